# Optimizing an MI355X kernel written in HIP

```python
import jax, jax.numpy as jnp
from jax import lax
import numpy as np

D_MODEL = 2048
BATCH = 4
SEQ = 2048
DEPTH = 2

N_MIXERS = 2
N_SUBLAYERS = 3
D_FF = 5632
POOL_GROUPS = 4
POOL_WINDOWS = (2, 4, 8, 16)
POOL_GROUP_DIM = D_MODEL // POOL_GROUPS
N_HEADS = 16
N_KV_HEADS = 4
KV_GROUP = N_HEADS // N_KV_HEADS
HEAD_DIM = D_MODEL // N_HEADS
ROT_DIM = HEAD_DIM // 4
ROPE_THETA = 500000.0
IDX_HEADS = 16
IDX_DIM = 64
IDX_ROT_DIM = IDX_DIM // 4
TOPK_MAX = 256
Q_BLOCK = 128
EPS = 1e-6
NEG = -1e30
Q_W = N_HEADS * HEAD_DIM
KV_W = N_KV_HEADS * HEAD_DIM
QI_W = IDX_HEADS * IDX_DIM
DSA_IN = Q_W + 2 * KV_W + QI_W + IDX_DIM + IDX_HEADS
DSA_SPLITS = (Q_W, Q_W + KV_W, Q_W + 2 * KV_W, Q_W + 2 * KV_W + QI_W,
              Q_W + 2 * KV_W + QI_W + IDX_DIM)
N_POOL_LAYERS = (DEPTH + 1) // 2
N_DSA_LAYERS = DEPTH // 2

kernel_name = "hybrid_pool_dsa_macaron_adaln"


def rmsnorm(h, g):
    hf = h.astype(jnp.float32)
    hf = hf * lax.rsqrt(jnp.mean(hf * hf, axis=-1, keepdims=True) + EPS)
    return (hf * g.astype(jnp.float32)).astype(h.dtype)


def modulate(h, shift, scale):
    return h * (1 + scale[:, None, :]) + shift[:, None, :]


def partial_rope(x, positions, rot_dim):
    half = rot_dim // 2
    inv_freq = ROPE_THETA ** (-jnp.arange(half, dtype=jnp.float32) / half)
    ang = positions.astype(jnp.float32)[..., None] * inv_freq
    cos = jnp.cos(ang)[:, :, None, :]
    sin = jnp.sin(ang)[:, :, None, :]
    xr = x[..., :rot_dim].astype(jnp.float32)
    x1, x2 = xr[..., :half], xr[..., half:]
    rot = jnp.concatenate([x1 * cos - x2 * sin, x2 * cos + x1 * sin], axis=-1)
    return jnp.concatenate([rot.astype(x.dtype), x[..., rot_dim:]], axis=-1)


def swiglu_ffn(h, w_gu, w_d):
    g, u = jnp.split(h @ w_gu, 2, axis=-1)
    return (jax.nn.silu(g) * u) @ w_d


def pool_mixer(h, w_in, w_grp, ls, w_out):
    B, S, _ = h.shape
    u = (h @ w_in).reshape(B, S, POOL_GROUPS, POOL_GROUP_DIM)
    cs = jnp.cumsum(u.astype(jnp.float32), axis=1)
    t = jnp.arange(S)
    outs = []
    for g, w in enumerate(POOL_WINDOWS):
        c_g = cs[:, :, g]
        c_lag = jnp.pad(c_g, ((0, 0), (w, 0), (0, 0)))[:, :S]
        cnt = jnp.minimum(t + 1, w).astype(jnp.float32)[None, :, None]
        outs.append(((c_g - c_lag) / cnt - u[:, :, g].astype(jnp.float32)).astype(h.dtype))
    p = jnp.stack(outs, axis=2)
    v = jnp.einsum('bsgc,gcd->bsgd', p, w_grp).reshape(B, S, D_MODEL)
    return (v * ls) @ w_out


def dsa_mixer(h, positions, w_in, w_out):
    B, S, _ = h.shape
    q, k, v, qi, ki, wi = jnp.split(h @ w_in, DSA_SPLITS, axis=-1)
    q = partial_rope(q.reshape(B, S, N_HEADS, HEAD_DIM), positions, ROT_DIM)
    k = partial_rope(k.reshape(B, S, N_KV_HEADS, HEAD_DIM), positions, ROT_DIM)
    v = v.reshape(B, S, N_KV_HEADS, HEAD_DIM)
    qi = partial_rope(qi.reshape(B, S, IDX_HEADS, IDX_DIM), positions, IDX_ROT_DIM)
    ki = partial_rope(ki.reshape(B, S, 1, IDX_DIM), positions, IDX_ROT_DIM)[:, :, 0]
    ki32 = ki.astype(jnp.float32)
    top_k = min(TOPK_MAX, S // 4)
    nb = S // Q_BLOCK
    key_pos = jnp.arange(S)
    bidx = jnp.arange(B)[:, None, None]

    def to_blocks(a):
        return jnp.moveaxis(a.reshape(B, nb, Q_BLOCK, *a.shape[2:]), 1, 0)

    def block(args):
        blk, q_b, qi_b, wi_b = args
        t_pos = blk * Q_BLOCK + jnp.arange(Q_BLOCK)
        causal = key_pos[None, :] <= t_pos[:, None]
        rel = jax.nn.relu(jnp.einsum('bthd,bsd->bths', qi_b.astype(jnp.float32), ki32))
        score = jnp.einsum('bths,bth->bts', rel, wi_b.astype(jnp.float32))
        score = jnp.where(causal[None], score, NEG)
        _, sel = lax.top_k(score, top_k)
        valid = sel <= t_pos[None, :, None]
        k_sel = k[bidx, sel]
        v_sel = v[bidx, sel]
        qg = q_b.reshape(B, Q_BLOCK, N_KV_HEADS, KV_GROUP, HEAD_DIM)
        logits = jnp.einsum('btgrd,btkgd->btgrk', qg.astype(jnp.float32),
                            k_sel.astype(jnp.float32)) * (HEAD_DIM ** -0.5)
        logits = jnp.where(valid[:, :, None, None, :], logits, NEG)
        prob = jax.nn.softmax(logits, axis=-1)
        o = jnp.einsum('btgrk,btkgd->btgrd', prob.astype(v.dtype), v_sel)
        return o.reshape(B, Q_BLOCK, Q_W)

    out = lax.map(block, (jnp.arange(nb), to_blocks(q), to_blocks(qi), to_blocks(wi)))
    out = jnp.moveaxis(out, 0, 1).reshape(B, S, Q_W)
    return out @ w_out


def setup_inputs(seed: int = 0) -> dict:
    key = jax.random.key(seed)
    ks = jax.random.split(key, 16)
    f32 = jnp.float32
    nrm = lambda k, shape, s: jax.random.normal(k, shape, f32) * s
    x = nrm(ks[0], (BATCH, SEQ, D_MODEL), 1.0)
    c = nrm(ks[1], (BATCH, D_MODEL), 1.0)
    offsets = jax.random.randint(ks[2], (BATCH, 1), 0, 1024, dtype=jnp.int32)
    positions = offsets + jnp.arange(SEQ, dtype=jnp.int32)[None, :]
    ada_w = nrm(ks[3], (DEPTH, D_MODEL, N_SUBLAYERS * 3 * D_MODEL), 0.02)
    ada_b = nrm(ks[4], (DEPTH, N_SUBLAYERS * 3 * D_MODEL), 0.02)
    norm_g = 1.0 + nrm(ks[5], (DEPTH, N_SUBLAYERS, D_MODEL), 0.02)
    final_g = 1.0 + nrm(ks[6], (D_MODEL,), 0.02)
    ffn_wgu = nrm(ks[7], (DEPTH, 2, D_MODEL, 2 * D_FF), D_MODEL ** -0.5)
    ffn_wd = nrm(ks[8], (DEPTH, 2, D_FF, D_MODEL), D_FF ** -0.5)
    pool_w_in = nrm(ks[9], (N_POOL_LAYERS, D_MODEL, D_MODEL), D_MODEL ** -0.5)
    pool_w_grp = nrm(ks[10], (N_POOL_LAYERS, POOL_GROUPS, POOL_GROUP_DIM, POOL_GROUP_DIM), POOL_GROUP_DIM ** -0.5)
    pool_scale = 1.0 + nrm(ks[11], (N_POOL_LAYERS, D_MODEL), 0.1)
    pool_w_out = nrm(ks[12], (N_POOL_LAYERS, D_MODEL, D_MODEL), D_MODEL ** -0.5)
    dsa_w_in = nrm(ks[13], (N_DSA_LAYERS, D_MODEL, DSA_IN), D_MODEL ** -0.5)
    dsa_w_out = nrm(ks[14], (N_DSA_LAYERS, Q_W, D_MODEL), Q_W ** -0.5)
    return {"x": x, "c": c, "positions": positions, "ada_w": ada_w, "ada_b": ada_b,
            "norm_g": norm_g, "final_g": final_g, "ffn_wgu": ffn_wgu, "ffn_wd": ffn_wd,
            "pool_w_in": pool_w_in, "pool_w_grp": pool_w_grp, "pool_scale": pool_scale,
            "pool_w_out": pool_w_out, "dsa_w_in": dsa_w_in, "dsa_w_out": dsa_w_out}


def reference(x, c, positions, ada_w, ada_b, norm_g, final_g, ffn_wgu, ffn_wd,
              pool_w_in, pool_w_grp, pool_scale, pool_w_out, dsa_w_in, dsa_w_out):
    B = x.shape[0]
    ada = jnp.einsum('bd,lde->ble', jax.nn.silu(c), ada_w) + ada_b[None]
    ada = ada.reshape(B, DEPTH, N_SUBLAYERS, 3, D_MODEL)
    h = x
    for i in range(DEPTH):
        m = ada[:, i]
        y = modulate(rmsnorm(h, norm_g[i, 0]), m[:, 0, 0], m[:, 0, 1])
        h = h + 0.5 * m[:, 0, 2][:, None, :] * swiglu_ffn(y, ffn_wgu[i, 0], ffn_wd[i, 0])
        y = modulate(rmsnorm(h, norm_g[i, 1]), m[:, 1, 0], m[:, 1, 1])
        j = i // N_MIXERS
        if i % N_MIXERS == 0:
            y = pool_mixer(y, pool_w_in[j], pool_w_grp[j], pool_scale[j], pool_w_out[j])
        else:
            y = dsa_mixer(y, positions, dsa_w_in[j], dsa_w_out[j])
        h = h + m[:, 1, 2][:, None, :] * y
        y = modulate(rmsnorm(h, norm_g[i, 2]), m[:, 2, 0], m[:, 2, 1])
        h = h + 0.5 * m[:, 2, 2][:, None, :] * swiglu_ffn(y, ffn_wgu[i, 1], ffn_wd[i, 1])
    return rmsnorm(h, final_g)
```

```cpp
#include <hip/hip_runtime.h>
#include <cstdint>
#include <cstdio>

namespace nv {
constexpr int B = 4, S = 2048, D = 2048, T = B * S, FF = 5632;
constexpr int NH = 16, NKV = 4, HD = 128, IH = 16, ID = 64, TOPK = 256;
constexpr int DSA_IN = 4176, OFF_K = 2048, OFF_V = 2560, OFF_QI = 3072, OFF_KI = 4096, OFF_WI = 4160;
constexpr float EPS = 1e-6f;

__device__ const float INVF_Q[16] = {1.0f, 0.44036659598350525f, 0.1939227432012558f, 0.08539710193872452f, 0.03760603070259094f, 0.01656043902039528f, 0.007292664609849453f, 0.0032114458736032248f,
                                     0.0014142135623842478f, 0.000622772378847003f, 0.00027424818836152554f, 0.00012076973507646471f, 5.318296098266728e-05f, 2.34199997066753e-05f, 1.0313386155758053e-05f, 4.541670477919979e-06f};
__device__ const float INVF_I[8] = {1.0f, 0.1939227432012558f, 0.03760603070259094f, 0.007292664609849453f, 0.0014142135623842478f, 0.00027424818836152554f, 5.318296098266728e-05f, 1.0313386155758053e-05f};

__device__ __forceinline__ void sincos_acc(float xf, float& sn, float& cs) {
    const double x = (double)xf;
    const double q = rint(x * 0.63661977236758134308);
    const double r = fma(-q, 1.57079632679489661923, x) - q * 6.123233995736766e-17;
    const double r2 = r * r;
    double sp = -2.5052108385441720e-08; sp = sp * r2 + 2.7557319223985893e-06; sp = sp * r2 - 1.9841269841269841e-04; sp = sp * r2 + 8.3333333333333332e-03; sp = sp * r2 - 1.6666666666666666e-01;
    const double s = r + r * r2 * sp;
    double cp = 2.0876756987868099e-09; cp = cp * r2 - 2.7557319223985888e-07; cp = cp * r2 + 2.4801587301587302e-05; cp = cp * r2 - 1.3888888888888889e-03; cp = cp * r2 + 4.1666666666666664e-02; cp = cp * r2 - 0.5;
    const double c = 1.0 + r2 * cp;
    const int qi = ((int)q) & 3;
    const double ss = (qi == 0) ? s : (qi == 1) ? c : (qi == 2) ? -s : -c;
    const double cc = (qi == 0) ? c : (qi == 1) ? -s : (qi == 2) ? -c : s;
    sn = (float)ss; cs = (float)cc;
}

__global__ __launch_bounds__(256) void k_ada(const float* __restrict__ c, const float* __restrict__ w, const float* __restrict__ bia, float* __restrict__ ada) {
    __shared__ float sc[4][D];
    for (int i = threadIdx.x; i < 4 * D; i += 256) { const float v = c[i]; sc[i / D][i % D] = v / (1.f + expf(-v)); }
    __syncthreads();
    const int l = blockIdx.y, e = blockIdx.x * 256 + threadIdx.x;
    const float* wp = w + (size_t)l * D * 18432 + e;
    float a0 = 0, a1 = 0, a2 = 0, a3 = 0;
    for (int d = 0; d < D; ++d) { const float x = wp[(size_t)d * 18432]; a0 += sc[0][d] * x; a1 += sc[1][d] * x; a2 += sc[2][d] * x; a3 += sc[3][d] * x; }
    const float bb = bia[l * 18432 + e];
    ada[(size_t)(0 * 2 + l) * 18432 + e] = a0 + bb; ada[(size_t)(1 * 2 + l) * 18432 + e] = a1 + bb;
    ada[(size_t)(2 * 2 + l) * 18432 + e] = a2 + bb; ada[(size_t)(3 * 2 + l) * 18432 + e] = a3 + bb;
}

__device__ __forceinline__ float block_sum256(float v, float* red) {
    for (int o = 32; o > 0; o >>= 1) v += __shfl_xor(v, o);
    const int w = threadIdx.x >> 6;
    __syncthreads();
    if ((threadIdx.x & 63) == 0) red[w] = v;
    __syncthreads();
    return red[0] + red[1] + red[2] + red[3];
}
__device__ __forceinline__ float block_max256(float v, float* red) {
    for (int o = 32; o > 0; o >>= 1) v = fmaxf(v, __shfl_xor(v, o));
    const int w = threadIdx.x >> 6;
    __syncthreads();
    if ((threadIdx.x & 63) == 0) red[w] = v;
    __syncthreads();
    return fmaxf(fmaxf(red[0], red[1]), fmaxf(red[2], red[3]));
}

__global__ __launch_bounds__(256) void k_norm(const float* h, const float* __restrict__ g, const float* __restrict__ ada, int l, int sub, float* y) {
    __shared__ float red[4];
    const int row = blockIdx.x, b = row / S;
    const float* hp = h + (size_t)row * D;
    float v[8]; float ss = 0.f;
#pragma unroll
    for (int i = 0; i < 8; ++i) { v[i] = hp[threadIdx.x + 256 * i]; ss += v[i] * v[i]; }
    ss = block_sum256(ss, red);
    const float rstd = 1.0f / sqrtf(ss * (1.0f / D) + EPS);
#pragma unroll
    for (int i = 0; i < 8; ++i) {
        const int d = threadIdx.x + 256 * i;
        float o = v[i] * rstd * g[d];
        if (l >= 0) { const float* m = ada + (size_t)(((b * 2 + l) * 3 + sub) * 3) * D; o = o * (1.f + m[D + d]) + m[d]; }
        y[(size_t)row * D + d] = o;
    }
}

__global__ __launch_bounds__(256) void k_gemm(const float* __restrict__ A, int lda, const float* __restrict__ W, int ldw, float* __restrict__ C, int ldc, int M, int N, int K) {
    __shared__ __attribute__((aligned(16))) float As[16][68];
    __shared__ __attribute__((aligned(16))) float Ws[16][68];
    const int tid = threadIdx.x, tx = tid & 15, ty = tid >> 4;
    const int m0 = blockIdx.y * 64, n0 = blockIdx.x * 64;
    float acc[4][4];
#pragma unroll
    for (int i = 0; i < 4; ++i)
#pragma unroll
        for (int j = 0; j < 4; ++j) acc[i][j] = 0.f;
    const int am = tid >> 2, ak = (tid & 3) * 4;
    const int wk = tid >> 4, wn = (tid & 15) * 4;
    for (int k0 = 0; k0 < K; k0 += 16) {
        const float4 av = *(const float4*)(A + (size_t)(m0 + am) * lda + k0 + ak);
        float4 wv = make_float4(0.f, 0.f, 0.f, 0.f);
        if (n0 + wn < N) wv = *(const float4*)(W + (size_t)(k0 + wk) * ldw + n0 + wn);
        As[ak + 0][am] = av.x; As[ak + 1][am] = av.y; As[ak + 2][am] = av.z; As[ak + 3][am] = av.w;
        *(float4*)&Ws[wk][wn] = wv;
        __syncthreads();
#pragma unroll
        for (int k = 0; k < 16; ++k) {
            const float4 a = *(const float4*)&As[k][ty * 4];
            const float4 w = *(const float4*)&Ws[k][tx * 4];
            const float aa[4] = {a.x, a.y, a.z, a.w}, ww[4] = {w.x, w.y, w.z, w.w};
#pragma unroll
            for (int i = 0; i < 4; ++i)
#pragma unroll
                for (int j = 0; j < 4; ++j) acc[i][j] += aa[i] * ww[j];
        }
        __syncthreads();
    }
    if (n0 + tx * 4 < N) {
#pragma unroll
        for (int i = 0; i < 4; ++i) *(float4*)(C + (size_t)(m0 + ty * 4 + i) * ldc + n0 + tx * 4) = make_float4(acc[i][0], acc[i][1], acc[i][2], acc[i][3]);
    }
}

__global__ void k_swiglu(const float* __restrict__ gu, float* __restrict__ act) {
    const size_t i = (size_t)blockIdx.x * 256 + threadIdx.x;
    const size_t t = i / FF; const int j = (int)(i % FF);
    const float g = gu[t * (2 * FF) + j], u = gu[t * (2 * FF) + FF + j];
    act[i] = g / (1.f + expf(-g)) * u;
}
__global__ void k_resid(float* __restrict__ h, const float* __restrict__ tmp, const float* __restrict__ ada, int l, int sub, float coef) {
    const size_t i = (size_t)blockIdx.x * 256 + threadIdx.x;
    const int row = (int)(i / D), d = (int)(i % D), b = row / S;
    const float gate = ada[(size_t)((((b * 2 + l) * 3 + sub) * 3) + 2) * D + d];
    h[i] += coef * gate * tmp[i];
}
__global__ void k_pool(const float* __restrict__ u, float* __restrict__ p) {
    const size_t i = (size_t)blockIdx.x * 256 + threadIdx.x;
    const int row = (int)(i / D), d = (int)(i % D), b = row / S, t = row % S, g = d / 512;
    const int w = 2 << g;
    int lo = t - w + 1; if (lo < 0) lo = 0;
    float s = 0.f;
    for (int j = lo; j <= t; ++j) s += u[(size_t)(b * S + j) * D + d];
    const float cnt = (float)((t + 1) < w ? (t + 1) : w);
    p[i] = s / cnt - u[i];
}
__global__ void k_scale(float* __restrict__ v, const float* __restrict__ ls) {
    const size_t i = (size_t)blockIdx.x * 256 + threadIdx.x;
    v[i] *= ls[i % D];
}
__global__ void k_rope(float* __restrict__ buf, const int* __restrict__ pos) {
    const int row = blockIdx.x;
    const float p = (float)pos[row];
    float* r = buf + (size_t)row * DSA_IN;
    for (int e = threadIdx.x; e < 456; e += 256) {
        int off, half, i;
        if (e < 256) { off = (e >> 4) * HD; half = 16; i = e & 15; }
        else if (e < 320) { const int f = e - 256; off = OFF_K + (f >> 4) * HD; half = 16; i = f & 15; }
        else if (e < 448) { const int f = e - 320; off = OFF_QI + (f >> 3) * ID; half = 8; i = f & 7; }
        else { const int f = e - 448; off = OFF_KI; half = 8; i = f; }
        const float ang = p * (half == 16 ? INVF_Q[i] : INVF_I[i]);
        float sn, cs; sincos_acc(ang, sn, cs);
        const float x1 = r[off + i], x2 = r[off + i + half];
        r[off + i] = x1 * cs - x2 * sn; r[off + i + half] = x2 * cs + x1 * sn;
    }
}
__global__ __launch_bounds__(256) void k_select(const float* __restrict__ buf, unsigned char* __restrict__ sel) {
    __shared__ float qs[IH * ID]; __shared__ float wsh[IH]; __shared__ float sc[S];
    const int row = blockIdx.x, b = row / S, t = row % S;
    const float* r = buf + (size_t)row * DSA_IN;
    for (int i = threadIdx.x; i < IH * ID; i += 256) qs[i] = r[OFF_QI + i];
    if (threadIdx.x < IH) wsh[threadIdx.x] = r[OFF_WI + threadIdx.x];
    __syncthreads();
    for (int s = threadIdx.x; s <= t; s += 256) {
        const float* kp = buf + (size_t)(b * S + s) * DSA_IN + OFF_KI;
        float kk[ID];
#pragma unroll
        for (int d = 0; d < ID; ++d) kk[d] = kp[d];
        float tot = 0.f;
        for (int h = 0; h < IH; ++h) { float a = 0.f;
#pragma unroll
            for (int d = 0; d < ID; ++d) a += qs[h * ID + d] * kk[d];
            tot += wsh[h] * fmaxf(a, 0.f); }
        sc[s] = tot;
    }
    __syncthreads();
    for (int s = threadIdx.x; s < S; s += 256) {
        unsigned char o = 0;
        if (s <= t) { const float v = sc[s]; int rank = 0;
            for (int j = 0; j <= t; ++j) { const float x = sc[j]; rank += (x > v || (x == v && j < s)) ? 1 : 0; }
            o = rank < TOPK ? 1 : 0; }
        sel[(size_t)row * S + s] = o;
    }
}
__global__ __launch_bounds__(256) void k_attn(const float* __restrict__ buf, const unsigned char* __restrict__ sel, float* __restrict__ o) {
    __shared__ int idx[TOPK]; __shared__ int cnts[256]; __shared__ float qs[NH * HD]; __shared__ float p[TOPK]; __shared__ float red[4];
    const int row = blockIdx.x, b = row / S, tid = threadIdx.x;
    const float* r = buf + (size_t)row * DSA_IN;
    for (int i = tid; i < NH * HD; i += 256) qs[i] = r[i];
    const unsigned char* sp = sel + (size_t)row * S + tid * 8;
    int c = 0;
#pragma unroll
    for (int j = 0; j < 8; ++j) c += sp[j];
    cnts[tid] = c;
    __syncthreads();
    if (tid == 0) { int a = 0; for (int i = 0; i < 256; ++i) { const int x = cnts[i]; cnts[i] = a; a += x; } }
    __syncthreads();
    int base = cnts[tid];
#pragma unroll
    for (int j = 0; j < 8; ++j) if (sp[j]) { if (base < TOPK) idx[base] = tid * 8 + j; ++base; }
    __syncthreads();
    __shared__ int ntot;
    if (tid == 255) ntot = base;
    __syncthreads();
    const int n = ntot < TOPK ? ntot : TOPK;
    const float scale = 0.08838834764831845f;
    for (int h = 0; h < NH; ++h) {
        const int g = h >> 2;
        float lg = -INFINITY;
        if (tid < n) { const float* kp = buf + (size_t)(b * S + idx[tid]) * DSA_IN + OFF_K + g * HD; float a = 0.f;
            for (int d = 0; d < HD; ++d) a += qs[h * HD + d] * kp[d];
            lg = a * scale; }
        const float mx = block_max256(lg, red);
        const float ex = (tid < n) ? expf(lg - mx) : 0.f;
        const float sm = block_sum256(ex, red);
        p[tid] = ex / sm;
        __syncthreads();
        if (tid < HD) { float a = 0.f;
            for (int k = 0; k < n; ++k) a += p[k] * buf[(size_t)(b * S + idx[k]) * DSA_IN + OFF_V + g * HD + tid];
            o[(size_t)row * D + h * HD + tid] = a; }
        __syncthreads();
    }
}
}

extern "C" void kernel_launch(void* const* d_in, const int* in_sizes, int n_in, void* d_out, int out_size, void* d_ws, size_t ws_size, hipStream_t stream) {
    using namespace nv;
    const float* x = (const float*)d_in[0]; const float* c = (const float*)d_in[1]; const int* pos = (const int*)d_in[2];
    const float* ada_w = (const float*)d_in[3]; const float* ada_b = (const float*)d_in[4]; const float* norm_g = (const float*)d_in[5];
    const float* final_g = (const float*)d_in[6]; const float* wgu = (const float*)d_in[7]; const float* wd = (const float*)d_in[8];
    const float* pw_in = (const float*)d_in[9]; const float* pw_grp = (const float*)d_in[10]; const float* p_scale = (const float*)d_in[11];
    const float* pw_out = (const float*)d_in[12]; const float* dw_in = (const float*)d_in[13]; const float* dw_out = (const float*)d_in[14];
    float* h = (float*)d_out;
    float* ws = (float*)d_ws;
    size_t o = 0;
    float* ADA = ws + o; o += 4 * 2 * 18432;
    float* Y = ws + o; o += (size_t)T * D;
    float* TMP = ws + o; o += (size_t)T * D;
    float* ACT = ws + o; o += (size_t)T * FF;
    float* GU = ws + o; o += (size_t)T * 2 * FF;
    float* OB = ws + o; o += (size_t)T * D;
    unsigned char* SEL = (unsigned char*)(ws + o); o += (size_t)T * S / 4;
    float* U = GU; float* P = GU + (size_t)T * D; float* V = GU + (size_t)2 * T * D; float* QKV = GU;
    (void)in_sizes; (void)n_in; (void)out_size; (void)ws_size;

    (void)hipMemcpyAsync(h, x, (size_t)T * D * sizeof(float), hipMemcpyDeviceToDevice, stream);
    k_ada<<<dim3(18432 / 256, 2), 256, 0, stream>>>(c, ada_w, ada_b, ADA);
    auto gemm = [&](const float* A, int lda, const float* W, int ldw, float* C, int ldc, int M, int N, int K) {
        k_gemm<<<dim3((N + 63) / 64, M / 64), 256, 0, stream>>>(A, lda, W, ldw, C, ldc, M, N, K);
    };
    const int EW = (int)((size_t)T * D / 256);
    for (int l = 0; l < 2; ++l) {
        for (int f = 0; f < 2; ++f) {
            const int sub = f == 0 ? 0 : 2;
            if (f == 1) {
                k_norm<<<T, 256, 0, stream>>>(h, norm_g + (size_t)(l * 3 + 1) * D, ADA, l, 1, Y);
                if (l == 0) {
                    gemm(Y, D, pw_in, D, U, D, T, D, D);
                    k_pool<<<EW, 256, 0, stream>>>(U, P);
                    for (int g = 0; g < 4; ++g) gemm(P + g * 512, D, pw_grp + (size_t)g * 512 * 512, 512, V + g * 512, D, T, 512, 512);
                    k_scale<<<EW, 256, 0, stream>>>(V, p_scale);
                    gemm(V, D, pw_out, D, TMP, D, T, D, D);
                } else {
                    gemm(Y, D, dw_in, DSA_IN, QKV, DSA_IN, T, DSA_IN, D);
                    k_rope<<<T, 256, 0, stream>>>(QKV, pos);
                    k_select<<<T, 256, 0, stream>>>(QKV, SEL);
                    k_attn<<<T, 256, 0, stream>>>(QKV, SEL, OB);
                    gemm(OB, D, dw_out, D, TMP, D, T, D, D);
                }
                k_resid<<<EW, 256, 0, stream>>>(h, TMP, ADA, l, 1, 1.0f);
            }
            k_norm<<<T, 256, 0, stream>>>(h, norm_g + (size_t)(l * 3 + sub) * D, ADA, l, sub, Y);
            gemm(Y, D, wgu + (size_t)(l * 2 + f) * D * 2 * FF, 2 * FF, GU, 2 * FF, T, 2 * FF, D);
            k_swiglu<<<(int)((size_t)T * FF / 256), 256, 0, stream>>>(GU, ACT);
            gemm(ACT, FF, wd + (size_t)(l * 2 + f) * FF * D, D, TMP, D, T, D, FF);
            k_resid<<<EW, 256, 0, stream>>>(h, TMP, ADA, l, sub, 0.5f);
        }
    }
    k_norm<<<T, 256, 0, stream>>>(h, final_g, ADA, -1, 0, h);
}
```

```cpp
#include <hip/hip_runtime.h>
#include <cstdio>
#include <cstdint>
#ifndef MK_N_LAUNCHES
#define MK_N_LAUNCHES 25
#endif

#define LAS __attribute__((address_space(3)))
#define GAS __attribute__((address_space(1)))
#define CAS __attribute__((address_space(4)))
typedef unsigned short bf16_t;
typedef short bf16x8 __attribute__((ext_vector_type(8)));
typedef short s16x4 __attribute__((ext_vector_type(4)));
typedef float f32x2 __attribute__((ext_vector_type(2)));
typedef float f32x4 __attribute__((ext_vector_type(4)));
typedef float f32x16 __attribute__((ext_vector_type(16)));
typedef unsigned u32x2 __attribute__((ext_vector_type(2)));
typedef unsigned u32x4 __attribute__((ext_vector_type(4)));
typedef GAS unsigned gu32;

constexpr int NB = 4, SEQ = 2048, DM = 2048, NTOK = NB * SEQ, FF = 5632;
constexpr int NHEAD = 16, NKVH = 4, HDIM = 128, IHEAD = 16, IDIM = 64, TOPK = 256;
constexpr int DSA_IN = 4176, DSA_NPAD = 4352;
constexpr float RMS_EPS = 1e-6f;
constexpr int ADA_E = 9 * DM;

constexpr size_t MiB = 1u << 20;
constexpr size_t WS_CTL = 0, CTL_ZERO_BYTES = 1 * MiB;
constexpr size_t WS_ADA = 1 * MiB;
constexpr size_t WS_COSQ = 2 * MiB, WS_SINQ = WS_COSQ + 512 * 1024;
constexpr size_t WS_COSI = 3 * MiB, WS_SINI = WS_COSI + 256 * 1024;
constexpr size_t WS_WI = WS_COSI + 512 * 1024;
constexpr size_t WS_KI = 4 * MiB;
constexpr size_t WS_MASK = 5 * MiB;
constexpr size_t WS_WGU = 8 * MiB;
constexpr size_t WS_WD = WS_WGU + 4 * 44 * MiB;
constexpr size_t WS_PWIN = WS_WD + 4 * 22 * MiB;
constexpr size_t WS_PWGRP = WS_PWIN + 8 * MiB;
constexpr size_t WS_PWOUT = WS_PWGRP + 2 * MiB;
constexpr size_t WS_DWIN = WS_PWOUT + 8 * MiB;
constexpr size_t WS_DWOUT = WS_DWIN + 17 * MiB;
constexpr size_t WS_Y = WS_DWOUT + 8 * MiB + 5 * MiB;
constexpr size_t WS_BIG = WS_Y + 32 * MiB;
constexpr size_t WS_O = WS_BIG + 96 * MiB;
constexpr size_t WS_END = WS_O + 32 * MiB;
static_assert(WS_Y == 320 * MiB, "ws map");
constexpr size_t BIG_U = 0, BIG_P = 32 * MiB, BIG_V = 64 * MiB;
constexpr size_t BIG_Q = 0, BIG_K = 32 * MiB, BIG_VV = 40 * MiB, BIG_QI = 48 * MiB, BIG_KWP = 64 * MiB;

constexpr int CW_TMO = 0, CW_QUEUE = 64, CW_BAR = 4096;

constexpr int RING_BYTES = 131072;
constexpr int LDSCTL_OFF = RING_BYTES, MISC_OFF = LDSCTL_OFF + 320;
constexpr int LDS_BYTES = 147456;
constexpr int NWAVES = 8;

#define LDS_WAIT() asm volatile("s_waitcnt lgkmcnt(0)" ::: "memory")
#define VM_WAIT() asm volatile("s_waitcnt vmcnt(0)" ::: "memory")
#define RLX_AGENT __ATOMIC_RELAXED, __HIP_MEMORY_SCOPE_AGENT

__device__ __forceinline__ unsigned cvt_pk_bf16(float lo, float hi) { unsigned r; asm volatile("v_cvt_pk_bf16_f32 %0, %1, %2" : "=v"(r) : "v"(lo), "v"(hi)); return r; }
__device__ __forceinline__ float bf_lo(unsigned w) { return __uint_as_float(w << 16); }
__device__ __forceinline__ float bf_hi(unsigned w) { return __uint_as_float(w & 0xffff0000u); }
__device__ __forceinline__ float wave_sum(float v) {
#pragma unroll
    for (int o = 1; o < 64; o <<= 1) v += __shfl_xor(v, o);
    return v;
}

__device__ const float INVF_Q[16] = {1.0f, 0.44036659598350525f, 0.1939227432012558f, 0.08539710193872452f, 0.03760603070259094f, 0.01656043902039528f, 0.007292664609849453f, 0.0032114458736032248f,
                                     0.0014142135623842478f, 0.000622772378847003f, 0.00027424818836152554f, 0.00012076973507646471f, 5.318296098266728e-05f, 2.34199997066753e-05f, 1.0313386155758053e-05f, 4.541670477919979e-06f};
__device__ const float INVF_I[8] = {1.0f, 0.1939227432012558f, 0.03760603070259094f, 0.007292664609849453f, 0.0014142135623842478f, 0.00027424818836152554f, 5.318296098266728e-05f, 1.0313386155758053e-05f};

__device__ __forceinline__ void sincos_acc(float xf, float& sn, float& cs) {
    const double x = (double)xf;
    const double q = rint(x * 0.63661977236758134308);
    const double r = fma(-q, 1.57079632679489661923, x) - q * 6.123233995736766e-17;
    const double r2 = r * r;
    double sp = -2.5052108385441720e-08; sp = sp * r2 + 2.7557319223985893e-06; sp = sp * r2 - 1.9841269841269841e-04; sp = sp * r2 + 8.3333333333333332e-03; sp = sp * r2 - 1.6666666666666666e-01;
    const double s = r + r * r2 * sp;
    double cp = 2.0876756987868099e-09; cp = cp * r2 - 2.7557319223985888e-07; cp = cp * r2 + 2.4801587301587302e-05; cp = cp * r2 - 1.3888888888888889e-03; cp = cp * r2 + 4.1666666666666664e-02; cp = cp * r2 - 0.5;
    const double c = 1.0 + r2 * cp;
    const int qi = ((int)q) & 3;
    const double ss = (qi == 0) ? s : (qi == 1) ? c : (qi == 2) ? -s : -c;
    const double cc = (qi == 0) ? c : (qi == 1) ? -s : (qi == 2) ? -c : s;
    sn = (float)ss; cs = (float)cc;
}

namespace pg8 {
#define PG8_LAS __attribute__((address_space(3)))
constexpr int BM = 256, BK = 64, HALF = 128, HTB = HALF * BK * 2, STAGE_BYTES = 8 * HTB, NXCD = 8, WGM = 8;
__host__ __device__ __forceinline__ int lds_byte(int r, int c) { const int st = (r >> 4) * 2 + (c >> 5), rr = r & 15, cc = c & 31, ob = rr * 64 + cc * 2; return st * 1024 + (ob ^ (((ob >> 9) & 1) << 5)); }
__host__ __device__ __forceinline__ void stage_rc(int b, int& R, int& C) { const int st = b / 1024, sb = b % 1024, swz = sb ^ (((sb >> 9) & 1) << 5); R = (st >> 1) * 16 + swz / 64; C = (st & 1) * 32 + (swz % 64) / 2; }
__host__ __device__ __forceinline__ int perm32(int rho) { const int n = rho >> 4, i = rho & 15; return 8 * (i >> 2) + 4 * n + (i & 3); }

struct Unit { int pm, pn; long aoff, boff; };
struct Gemm { const bf16_t* A; const bf16_t* Bt; int lda, ldb, K; };

struct StaticOrder {
    int nM, nN, nwg, G, c, a_sh; long a_m, a_n, b_n;
    __device__ void init(int nM_, int nN_, int G_, int c_, long a_m_, int a_sh_, long a_n_, long b_n_) { nM = nM_; nN = nN_; nwg = nM * nN; G = G_; c = c_; a_m = a_m_; a_sh = a_sh_; a_n = a_n_; b_n = b_n_; }
    __device__ bool next(int i, Unit& u) const {
        const long L = (long)i * G + c; if (L >= nwg) return false;
        int wgid = (int)L; { const int q = nwg / NXCD, r = nwg % NXCD, xcd = wgid % NXCD, off = wgid / NXCD; wgid = (xcd < r ? xcd * (q + 1) : r * (q + 1) + (xcd - r) * q) + off; }
        const int nig = WGM * nN, gid = wgid / nig, fm = gid * WGM, gsz = (nM - fm) < WGM ? (nM - fm) : WGM;
        u.pm = fm + ((wgid % nig) % gsz); u.pn = (wgid % nig) / gsz;
        u.aoff = (long)u.pm * a_m + (long)(u.pn >> a_sh) * a_n; u.boff = (long)u.pn * b_n; return true;
    }
    __device__ __forceinline__ void a_ready(const Unit&) const {}
    __device__ __forceinline__ void done(const Unit&) const {}
};

__device__ __forceinline__ u32x4 pack8(const f32x4& v0, const f32x4& v1) { u32x4 w; w.x = cvt_pk_bf16(v0[0], v0[1]); w.y = cvt_pk_bf16(v0[2], v0[3]); w.z = cvt_pk_bf16(v1[0], v1[1]); w.w = cvt_pk_bf16(v1[2], v1[3]); return w; }

struct EpiBf16 {
    static constexpr bool PERM = true, AFTER_DRAIN = false;
    bf16_t* O; int ldc;
    __device__ __forceinline__ void operator()(const f32x4 (&acc)[2][2][4][2], const Unit& u, int wr, int wc, int fr, int fq) const {
        const int row0 = u.pm * BM + wr * 64 + fr, col0 = u.pn * BM + wc * 32 + 8 * fq;
#pragma unroll
        for (int ai = 0; ai < 2; ++ai)
#pragma unroll
            for (int m = 0; m < 4; ++m) { bf16_t* rowp = O + (size_t)(row0 + ai * HALF + m * 16) * ldc + col0;
#pragma unroll
                for (int bj = 0; bj < 2; ++bj) *(u32x4*)(rowp + bj * HALF) = pack8(acc[ai][bj][m][0], acc[ai][bj][m][1]); }
    }
};
struct EpiSwiglu {
    static constexpr bool PERM = true, AFTER_DRAIN = false;
    bf16_t* O; int ldc;
    __device__ __forceinline__ void operator()(const f32x4 (&acc)[2][2][4][2], const Unit& u, int wr, int wc, int fr, int fq) const {
        const int row0 = u.pm * BM + wr * 64 + fr, col0 = u.pn * HALF + wc * 32 + 8 * fq;
#pragma unroll
        for (int ai = 0; ai < 2; ++ai)
#pragma unroll
            for (int m = 0; m < 4; ++m) {
                f32x4 o[2];
#pragma unroll
                for (int n = 0; n < 2; ++n)
#pragma unroll
                    for (int e = 0; e < 4; ++e) { const float g = acc[ai][0][m][n][e], uu = acc[ai][1][m][n][e];
                        o[n][e] = g * uu * __builtin_amdgcn_rcpf(1.0f + __builtin_amdgcn_exp2f(-1.4426950408889634f * g)); }
                *(u32x4*)(O + (size_t)(row0 + ai * HALF + m * 16) * ldc + col0) = pack8(o[0], o[1]); }
    }
};
struct EpiResid {
    static constexpr bool PERM = false, AFTER_DRAIN = false;
    float* H; const float* gate0; float coef;
    __device__ __forceinline__ void operator()(const f32x4 (&acc)[2][2][4][2], const Unit& u, int wr, int wc, int fr, int fq) const {
        const int row0 = u.pm * BM + wr * 64 + fr, col0 = u.pn * BM + wc * 32 + 4 * fq;
        const float* gp = gate0 + (size_t)(u.pm >> 3) * (2 * ADA_E) + col0;
        f32x4 gv[2][2];
#pragma unroll
        for (int bj = 0; bj < 2; ++bj)
#pragma unroll
            for (int n = 0; n < 2; ++n) gv[bj][n] = *(const f32x4*)(gp + bj * HALF + n * 16) * coef;
#pragma unroll
        for (int ai = 0; ai < 2; ++ai)
#pragma unroll
            for (int m = 0; m < 4; ++m) { float* rowp = H + (size_t)(row0 + ai * HALF + m * 16) * DM + col0;
#pragma unroll
                for (int bj = 0; bj < 2; ++bj)
#pragma unroll
                    for (int n = 0; n < 2; ++n) { f32x4* p = (f32x4*)(rowp + bj * HALF + n * 16); *p = *p + gv[bj][n] * acc[ai][bj][m][n]; }
                if (m & 1) asm volatile("" ::: "memory"); }
    }
};
struct EpiDsaIn {
    static constexpr bool PERM = true, AFTER_DRAIN = false;
    bf16_t *Q, *K, *V, *QI; const float *cosq, *sinq, *cosi, *sini;
    __device__ __forceinline__ void operator()(const f32x4 (&acc)[2][2][4][2], const Unit& u, int wr, int wc, int fr, int fq) const {
        const int row0 = u.pm * BM + wr * 64 + fr, pn = u.pn;
        bf16_t* base; int ldc, colt; int mode;
        if (pn < 8) { base = Q; ldc = DM; colt = pn * BM; mode = (wc == 0) ? 1 : 0; }
        else if (pn < 10) { base = K; ldc = 512; colt = (pn - 8) * BM; mode = (wc == 0) ? 1 : 0; }
        else if (pn < 12) { base = V; ldc = 512; colt = (pn - 10) * BM; mode = 0; }
        else { base = QI; ldc = 1024; colt = (pn - 12) * BM; mode = ((wc & 1) == 0 && fq < 2) ? 2 : 0; }
        const int col0 = colt + wc * 32 + 8 * fq;
#pragma unroll
        for (int ai = 0; ai < 2; ++ai)
#pragma unroll
            for (int m = 0; m < 4; ++m) { const int row = row0 + ai * HALF + m * 16;
                f32x4 cs = {1.f, 1.f, 1.f, 1.f}, sn = {0.f, 0.f, 0.f, 0.f};
                if (mode == 1) { cs = *(const f32x4*)(cosq + (size_t)row * 16 + 4 * fq); sn = *(const f32x4*)(sinq + (size_t)row * 16 + 4 * fq); }
                else if (mode == 2) { cs = *(const f32x4*)(cosi + (size_t)row * 8 + 4 * fq); sn = *(const f32x4*)(sini + (size_t)row * 8 + 4 * fq); }
#pragma unroll
                for (int bj = 0; bj < 2; ++bj) { const f32x4 a = acc[ai][bj][m][0], b = acc[ai][bj][m][1]; f32x4 oa, ob;
                    oa[0] = a[0] * cs[0] - a[1] * sn[0]; oa[1] = a[1] * cs[0] + a[0] * sn[0]; oa[2] = a[2] * cs[1] - a[3] * sn[1]; oa[3] = a[3] * cs[1] + a[2] * sn[1];
                    ob[0] = b[0] * cs[2] - b[1] * sn[2]; ob[1] = b[1] * cs[2] + b[0] * sn[2]; ob[2] = b[2] * cs[3] - b[3] * sn[3]; ob[3] = b[3] * cs[3] + b[2] * sn[3];
                    *(u32x4*)(base + (size_t)row * ldc + col0 + bj * HALF) = pack8(oa, ob); } }
    }
};
struct EpiKW {
    static constexpr bool PERM = false, AFTER_DRAIN = false;
    float* P;
    __device__ __forceinline__ void operator()(const f32x4 (&acc)[2][2][4][2], const Unit& u, int wr, int wc, int fr, int fq) const {
        const int row0 = u.pm * BM + wr * 64 + fr, col0 = wc * 32 + 4 * fq;
        float* pb = P + (size_t)u.pn * NTOK * 128;
#pragma unroll
        for (int ai = 0; ai < 2; ++ai)
#pragma unroll
            for (int m = 0; m < 4; ++m) { float* rowp = pb + (size_t)(row0 + ai * HALF + m * 16) * 128 + col0;
#pragma unroll
                for (int n = 0; n < 2; ++n) *(f32x4*)(rowp + n * 16) = acc[ai][0][m][n]; }
    }
};

template <class Epi, class Sched, bool ALIGN_EPI = false, bool SP2 = false>
__device__ __forceinline__ void gemm_phase(PG8_LAS unsigned char* lds, const Gemm g, const Sched& S, const Epi& E) {
    int tid_ = threadIdx.x; asm volatile("" : "+v"(tid_));
    const int tid = tid_, wid = __builtin_amdgcn_readfirstlane(tid >> 6), lane = tid & 63, wr = wid >> 2, wc = wid & 3, fr = lane & 15, fq = lane >> 4;
    const int K = g.K, nt = K / BK;
    unsigned voffA[2], voffB[2];
#pragma unroll
    for (int i = 0; i < 2; ++i) { int R, C; stage_rc(tid * 16 + i * 8192, R, C); const int Rb = Epi::PERM ? ((R & ~31) + perm32(R & 31)) : R;
        voffA[i] = (unsigned)(R * g.lda + C) * 2u; voffB[i] = (unsigned)(Rb * g.ldb + C) * 2u; }
    const size_t kstep = (size_t)(BK * 2);
    const size_t hstepA = (size_t)HALF * g.lda * 2, hstepB = (size_t)HALF * g.ldb * 2;
    const unsigned ldsw = (unsigned)wid * 1024u;
    const int aoff = lds_byte(wr * 64 + fr, fq * 8), boff = lds_byte(wc * 32 + fr, fq * 8);
#define PG8_SA(b, h) (((b) * 2 + (h)) * HTB)
#define PG8_SB(b, h) ((4 + (b) * 2 + (h)) * HTB)
#define PG8_STAGE(bufoff, gbase, voff) do { _Pragma("unroll") for (int _i = 0; _i < 2; ++_i) \
        __builtin_amdgcn_global_load_lds((const unsigned*)((const char*)(gbase) + (voff)[_i]), (PG8_LAS unsigned*)(lds + (bufoff) + ldsw + _i * 8192), 16, 0, 0); } while (0)
#define PG8_LDA(dst, b, h) do { _Pragma("unroll") for (int m = 0; m < 4; ++m) _Pragma("unroll") for (int k = 0; k < 2; ++k) dst[m][k] = *(const PG8_LAS bf16x8*)(lds + PG8_SA(b, h) + aoff + m * 2048 + k * 1024); } while (0)
#define PG8_LDB(dst, b, h) do { _Pragma("unroll") for (int n = 0; n < 2; ++n) _Pragma("unroll") for (int k = 0; k < 2; ++k) dst[n][k] = *(const PG8_LAS bf16x8*)(lds + PG8_SB(b, h) + boff + n * 2048 + k * 1024); } while (0)
#define PG8_MMA(ai, bj, At, Bt) do { __builtin_amdgcn_s_setprio(1); _Pragma("unroll") for (int m = 0; m < 4; ++m) _Pragma("unroll") for (int n = 0; n < 2; ++n) _Pragma("unroll") for (int k = 0; k < 2; ++k) \
        acc[ai][bj][m][n] = __builtin_amdgcn_mfma_f32_16x16x32_bf16(Bt[n][k], At[m][k], acc[ai][bj][m][n], 0, 0, 0); __builtin_amdgcn_s_setprio(0); } while (0)
#define PG8_WAIT_V(n) asm volatile("s_waitcnt vmcnt(" #n ")" ::: "memory")
#define PG8_WAIT_L(n) asm volatile("s_waitcnt lgkmcnt(" #n ")" ::: "memory")
#define PG8_BAR __builtin_amdgcn_s_barrier()
#define PG8_SCHED __builtin_amdgcn_sched_barrier(0)
    Unit cur, nxt; int ui = 0;
    if (!S.next(0, cur)) return;
    f32x4 acc[2][2][4][2];
#pragma unroll
    for (int a = 0; a < 2; ++a)
#pragma unroll
        for (int b = 0; b < 2; ++b)
#pragma unroll
            for (int m = 0; m < 4; ++m)
#pragma unroll
                for (int n = 0; n < 2; ++n) acc[a][b][m][n] = (f32x4){0.f, 0.f, 0.f, 0.f};
    bf16x8 At[4][2], B0[2][2], B1[2][2];
    const char* cA = (const char*)g.A + cur.aoff; const char* cB = (const char*)g.Bt + cur.boff;
    S.a_ready(cur);
    if constexpr (SP2) {
        PG8_STAGE(PG8_SB(0, 0), cB, voffB); PG8_STAGE(PG8_SB(0, 1), cB + hstepB, voffB); PG8_STAGE(PG8_SA(0, 0), cA, voffA); PG8_STAGE(PG8_SA(0, 1), cA + hstepA, voffA);
        if (wr == 1) PG8_BAR;
        PG8_WAIT_V(2); PG8_BAR;
        PG8_STAGE(PG8_SB(1, 0), cB + kstep, voffB); PG8_STAGE(PG8_SA(1, 0), cA + kstep, voffA); PG8_STAGE(PG8_SB(1, 1), cB + hstepB + kstep, voffB);
        PG8_WAIT_V(6); PG8_BAR;
    } else {
        PG8_STAGE(PG8_SB(0, 0), cB, voffB); PG8_STAGE(PG8_SA(0, 0), cA, voffA); PG8_STAGE(PG8_SB(0, 1), cB + hstepB, voffB); PG8_STAGE(PG8_SA(0, 1), cA + hstepA, voffA);
        if (wr == 1) PG8_BAR;
        PG8_WAIT_V(4); PG8_BAR;
        PG8_STAGE(PG8_SB(1, 0), cB + kstep, voffB); PG8_STAGE(PG8_SA(1, 0), cA + kstep, voffA); PG8_STAGE(PG8_SB(1, 1), cB + hstepB + kstep, voffB);
        PG8_WAIT_V(6); PG8_BAR;
    }
    for (;;) {
        const bool has_next = S.next(ui + 1, nxt);
        const char* nA = has_next ? (const char*)g.A + nxt.aoff : cA; const char* nB = has_next ? (const char*)g.Bt + nxt.boff : cB;
        for (int t = 0; t < nt; t += 2) {
            const bool last = (t == nt - 2);
            const char* a1 = cA + (size_t)(t + 1) * kstep;
            const char* a2 = last ? nA : cA + (size_t)(t + 2) * kstep; const char* b2 = last ? nB : cB + (size_t)(t + 2) * kstep;
            const char* a3 = a2 + kstep; const char* b3 = b2 + kstep;
            if (last && has_next) S.a_ready(nxt);
            if constexpr (SP2) {
            PG8_LDB(B0, 0, 0); PG8_LDB(B1, 0, 1); PG8_SCHED; PG8_LDA(At, 0, 0); PG8_STAGE(PG8_SA(1, 1), a1 + hstepA, voffA);
            PG8_WAIT_V(8); PG8_WAIT_L(0); PG8_BAR; PG8_MMA(0, 0, At, B0); PG8_MMA(0, 1, At, B1); PG8_BAR; PG8_SCHED;
            PG8_LDA(At, 0, 1); PG8_STAGE(PG8_SB(0, 0), b2, voffB); PG8_STAGE(PG8_SB(0, 1), b2 + hstepB, voffB); PG8_STAGE(PG8_SA(0, 0), a2, voffA);
            PG8_WAIT_V(8); PG8_WAIT_L(0); PG8_BAR; PG8_MMA(1, 0, At, B0); PG8_MMA(1, 1, At, B1); PG8_BAR; PG8_SCHED;
            PG8_LDB(B0, 1, 0); PG8_LDB(B1, 1, 1); PG8_SCHED; PG8_LDA(At, 1, 0); PG8_STAGE(PG8_SA(0, 1), a2 + hstepA, voffA);
            PG8_WAIT_V(8); PG8_WAIT_L(0); PG8_BAR; PG8_MMA(0, 0, At, B0); PG8_MMA(0, 1, At, B1); PG8_BAR; PG8_SCHED;
            PG8_LDA(At, 1, 1); PG8_STAGE(PG8_SB(1, 0), b3, voffB); PG8_STAGE(PG8_SB(1, 1), b3 + hstepB, voffB); PG8_STAGE(PG8_SA(1, 0), a3, voffA);
            PG8_WAIT_V(8); PG8_WAIT_L(0); PG8_BAR; PG8_MMA(1, 0, At, B0); PG8_MMA(1, 1, At, B1); PG8_BAR; PG8_SCHED;
            } else {
            PG8_LDB(B0, 0, 0); PG8_SCHED; PG8_LDA(At, 0, 0); PG8_STAGE(PG8_SA(1, 1), a1 + hstepA, voffA);
            PG8_WAIT_L(8); PG8_BAR; PG8_WAIT_L(0); PG8_MMA(0, 0, At, B0); PG8_BAR; PG8_SCHED;
            PG8_LDB(B1, 0, 1); PG8_STAGE(PG8_SB(0, 0), b2, voffB);
            PG8_BAR; PG8_WAIT_L(0); PG8_MMA(0, 1, At, B1); PG8_BAR;
            PG8_LDA(At, 0, 1); PG8_STAGE(PG8_SA(0, 0), a2, voffA);
            PG8_BAR; PG8_WAIT_L(0); PG8_MMA(1, 0, At, B0); PG8_BAR; PG8_SCHED;
            PG8_STAGE(PG8_SB(0, 1), b2 + hstepB, voffB);
            PG8_WAIT_V(6); PG8_BAR; PG8_MMA(1, 1, At, B1); PG8_BAR;
            PG8_LDB(B0, 1, 0); PG8_SCHED; PG8_LDA(At, 1, 0); PG8_STAGE(PG8_SA(0, 1), a2 + hstepA, voffA);
            PG8_WAIT_L(8); PG8_BAR; PG8_WAIT_L(0); PG8_MMA(0, 0, At, B0); PG8_BAR; PG8_SCHED;
            PG8_LDB(B1, 1, 1); PG8_STAGE(PG8_SB(1, 0), b3, voffB);
            PG8_BAR; PG8_WAIT_L(0); PG8_MMA(0, 1, At, B1); PG8_BAR;
            PG8_LDA(At, 1, 1); PG8_STAGE(PG8_SA(1, 0), a3, voffA);
            PG8_BAR; PG8_WAIT_L(0); PG8_MMA(1, 0, At, B0); PG8_BAR; PG8_SCHED;
            PG8_STAGE(PG8_SB(1, 1), b3 + hstepB, voffB);
            PG8_WAIT_V(6); PG8_BAR; PG8_MMA(1, 1, At, B1); PG8_BAR;
            }
        }
        if constexpr (ALIGN_EPI) { if (wr == 0) PG8_BAR; }
        if constexpr (!Epi::AFTER_DRAIN) { E(acc, cur, wr, wc, fr, fq); S.done(cur); }
        if (!has_next) break;
#pragma unroll
        for (int a = 0; a < 2; ++a)
#pragma unroll
            for (int b = 0; b < 2; ++b)
#pragma unroll
                for (int m = 0; m < 4; ++m)
#pragma unroll
                    for (int n = 0; n < 2; ++n) acc[a][b][m][n] = (f32x4){0.f, 0.f, 0.f, 0.f};
        cur = nxt; cA = nA; cB = nB; ++ui;
        if constexpr (ALIGN_EPI) { if (wr == 1) PG8_BAR; }
    }
    PG8_WAIT_V(0);
    if constexpr (!ALIGN_EPI) { if (wr == 0) PG8_BAR; }
    PG8_BAR;
    if constexpr (Epi::AFTER_DRAIN) { E.fused(acc, cur, wr, wc, fr, fq, lds, wid, lane); S.done(cur); }
#undef PG8_SA
#undef PG8_SB
#undef PG8_STAGE
#undef PG8_LDA
#undef PG8_LDB
#undef PG8_MMA
#undef PG8_WAIT_V
#undef PG8_WAIT_L
#undef PG8_BAR
#undef PG8_SCHED
}
}

namespace attn {
constexpr int D = 128, QS = 2048, KS = 512, OS = 2048;
constexpr float SCALE = 0.08838834764831845f;
constexpr float THR = 8.f;
constexpr int NW = 8, QBLK = 32, KVBLK = 64, QB = NW * QBLK;
constexpr int SHM_V = KVBLK * D * 2, SHM_K = KVBLK * D * 2;
constexpr int ATT_LDS = 2 * SHM_V + 2 * SHM_K + NW * 64 * 4;
typedef const CAS unsigned long long* cu64p;

#define KSWZ(row, colB) ((row) * 256 + ((colB) ^ (((row) & 7) << 4)))
#define SBAR() __builtin_amdgcn_sched_barrier(0)
__device__ __forceinline__ int v_st(int k, int c) { const int kk = (k & ~0xC) | ((k & 4) << 1) | ((k & 8) >> 1); return ((kk >> 3) * 4 + (c >> 5)) * 512 + ((kk & 7) * 32 + (c & 31)) * 2; }
__device__ __forceinline__ int v_rd_base(int lane) { return ((lane & 3) << 3) | (((lane >> 2) & 3) << 6) | (((lane >> 4) & 1) << 5) | (((lane >> 5) & 1) << 8); }
constexpr int v_rd_off(int d0, int ks, int half) { return d0 * 512 + ks * 4096 + half * 2048; }
__device__ __forceinline__ int crow(int r, int hi) { return (r & 3) + 8 * (r >> 2) + 4 * hi; }
__device__ __forceinline__ unsigned cvtpk(float lo, float hi) { unsigned r; asm volatile("v_cvt_pk_bf16_f32 %0, %1, %2" : "=v"(r) : "v"(lo), "v"(hi)); return r; }
__device__ __forceinline__ bf16x8 load8(const bf16_t* p) { return *reinterpret_cast<const bf16x8*>(p); }

__device__ __forceinline__ void mask_sel(f32x16& p0, f32x16& p1, cu64p mw) {
    const float NEG = -__builtin_inff();
#pragma unroll
    for (int r = 0; r < 16; ++r) { const unsigned long long w0 = mw[r]; p0[r] = __builtin_amdgcn_inverse_ballot_w64(w0) ? p0[r] : NEG; }
    __builtin_amdgcn_sched_barrier(0);
#pragma unroll
    for (int r = 0; r < 16; ++r) { const unsigned long long w1 = mw[16 + r]; p1[r] = __builtin_amdgcn_inverse_ballot_w64(w1) ? p1[r] : NEG; }
}
__device__ __forceinline__ void partialSM(f32x16& p0, f32x16& p1, float& m_reg, float& mn, float& alpha) {
    float pmax = p0[0];
#pragma unroll
    for (int r = 1; r < 16; ++r) pmax = fmaxf(pmax, p0[r]);
#pragma unroll
    for (int r = 0; r < 16; ++r) pmax = fmaxf(pmax, p1[r]);
    { auto rr = __builtin_amdgcn_permlane32_swap(__float_as_uint(pmax), __float_as_uint(pmax), false, false);
      pmax = fmaxf(__uint_as_float(rr[0]), __uint_as_float(rr[1])); }
    constexpr float C2 = 1.4426950408889634f * SCALE;
    if (__builtin_expect(__all((pmax - m_reg) * SCALE <= THR), 1)) { mn = m_reg; alpha = 1.f; }
    else { mn = fmaxf(m_reg, pmax); alpha = __builtin_amdgcn_exp2f((m_reg - mn) * C2); m_reg = mn; }
    const float mnL = -mn * C2;
#pragma unroll
    for (int r = 0; r < 16; ++r) p0[r] = fmaf(p0[r], C2, mnL);
#pragma unroll
    for (int r = 0; r < 16; ++r) p1[r] = fmaf(p1[r], C2, mnL);
#pragma unroll
    for (int r = 0; r < 16; ++r) p0[r] = __builtin_amdgcn_exp2f(p0[r]);
}
__device__ __forceinline__ void finishSM(f32x16& p0, f32x16& p1, float alpha, float& l_reg, bf16x8& pa0, bf16x8& pa1, bf16x8& pa2, bf16x8& pa3) {
#pragma unroll
    for (int r = 0; r < 16; ++r) p1[r] = __builtin_amdgcn_exp2f(p1[r]);
    float ps = 0;
#pragma unroll
    for (int r = 0; r < 16; ++r) ps += p0[r];
#pragma unroll
    for (int r = 0; r < 16; ++r) ps += p1[r];
    { auto rr = __builtin_amdgcn_permlane32_swap(__float_as_uint(ps), __float_as_uint(ps), false, false);
      ps = __uint_as_float(rr[0]) + __uint_as_float(rr[1]); }
    l_reg = l_reg * alpha + ps;
#define PK4(P, B_, OUT) do { unsigned a0 = cvtpk(P[B_+0], P[B_+1]), a1 = cvtpk(P[B_+2], P[B_+3]);                          \
        unsigned b0 = cvtpk(P[B_+4], P[B_+5]), b1 = cvtpk(P[B_+6], P[B_+7]);                                             \
        auto r0 = __builtin_amdgcn_permlane32_swap(a0, b0, false, false); auto r1 = __builtin_amdgcn_permlane32_swap(a1, b1, false, false); \
        u32x4 w = {r0[0], r1[0], r0[1], r1[1]}; OUT = *reinterpret_cast<bf16x8*>(&w); } while (0)
    PK4(p0, 0, pa0); PK4(p0, 8, pa1); PK4(p1, 0, pa2); PK4(p1, 8, pa3);
#undef PK4
}
template <int KB>
__device__ __forceinline__ void qkt(f32x16& p0, f32x16& p1, const char* K_lds, int r32, int hi, const bf16x8* qr) {
    p0 = f32x16{}; p1 = f32x16{};
    const char* kb[4];
#pragma unroll
    for (int dd = 0; dd < 4; ++dd) kb[dd] = K_lds + KB * SHM_K + KSWZ(r32, (dd * 16 + hi * 8) * 2);
#pragma unroll
    for (int d0 = 0; d0 < 8; ++d0) { const char* a = kb[d0 & 3] + (d0 >> 2) * 128;
        bf16x8 b0 = *reinterpret_cast<const bf16x8*>(a);
        bf16x8 b1 = *reinterpret_cast<const bf16x8*>(a + 32 * 256);
        p0 = __builtin_amdgcn_mfma_f32_32x32x16_bf16(b0, qr[d0], p0, 0, 0, 0);
        p1 = __builtin_amdgcn_mfma_f32_32x32x16_bf16(b1, qr[d0], p1, 0, 0, 0); }
}
template <int VB>
__device__ __forceinline__ void pv_tile(f32x16* o, int vb0, bf16x8 pa0, bf16x8 pa1, bf16x8 pa2, bf16x8 pa3) {
#define TRRD(dst, off) asm volatile("ds_read_b64_tr_b16 %0, %1 offset:%2" : "=&v"(dst) : "v"(vb0), "i"(off) : "memory")
#define PV_D0(d0) do { s16x4 l0, l1, l2, l3, h0, h1, h2, h3; constexpr int b_ = VB * SHM_V + v_rd_off(d0, 0, 0); \
        TRRD(l0, b_); TRRD(h0, b_ + 2048); TRRD(l1, b_ + 4096); TRRD(h1, b_ + 6144); TRRD(l2, b_ + 8192); TRRD(h2, b_ + 10240); TRRD(l3, b_ + 12288); TRRD(h3, b_ + 14336); \
        asm volatile("s_waitcnt lgkmcnt(0)" ::: "memory"); SBAR();   \
        o[d0] = __builtin_amdgcn_mfma_f32_32x32x16_bf16(pa0, (bf16x8){l0[0], l0[1], l0[2], l0[3], h0[0], h0[1], h0[2], h0[3]}, o[d0], 0, 0, 0);   \
        o[d0] = __builtin_amdgcn_mfma_f32_32x32x16_bf16(pa1, (bf16x8){l1[0], l1[1], l1[2], l1[3], h1[0], h1[1], h1[2], h1[3]}, o[d0], 0, 0, 0);   \
        o[d0] = __builtin_amdgcn_mfma_f32_32x32x16_bf16(pa2, (bf16x8){l2[0], l2[1], l2[2], l2[3], h2[0], h2[1], h2[2], h2[3]}, o[d0], 0, 0, 0);   \
        o[d0] = __builtin_amdgcn_mfma_f32_32x32x16_bf16(pa3, (bf16x8){l3[0], l3[1], l3[2], l3[3], h3[0], h3[1], h3[2], h3[3]}, o[d0], 0, 0, 0); } while (0)
    PV_D0(0); PV_D0(1); PV_D0(2); PV_D0(3);
#undef PV_D0
#undef TRRD
}

struct BlockRef { const bf16_t* Q; const bf16_t* K; const bf16_t* V; bf16_t* O; cu64p M; int P0; };
struct Seam { bf16x8 qr[8]; bf16x8 st_v0, st_v1, st_k0, st_k1; };
#define ROW(p, k0, rr) ((p) + (size_t)((k0) + (rr)) * KS + sc)
#define VMW() asm volatile("s_waitcnt vmcnt(0)" ::: "memory")
#define VMWN(n) asm volatile("s_waitcnt vmcnt(%0)" :: "i"(n) : "memory")
#define SLOAD_H(Kp, Vp, k0) do { S.st_v0 = load8(ROW(Vp, k0, sr)); S.st_v1 = load8(ROW(Vp, k0, 32 + sr));              \
                         S.st_k0 = load8(ROW(Kp, k0, sr)); S.st_k1 = load8(ROW(Kp, k0, 32 + sr)); } while (0)
#define SWRITE_HK(bf) do { *(bf16x8*)(K_lds + (bf) * SHM_K + kws) = S.st_k0; *(bf16x8*)(K_lds + (bf) * SHM_K + kws + 32 * 256) = S.st_k1; } while (0)
#define SWRITE_HV(bf) do { *(bf16x8*)(V_lds + (bf) * SHM_V + vst0) = S.st_v0; *(bf16x8*)(V_lds + (bf) * SHM_V + vst1) = S.st_v1; } while (0)
#define SWRITE_H(bf) do { SWRITE_HV(bf); SWRITE_HK(bf); } while (0)
__device__ __forceinline__ void attn_prime(const BlockRef& cur, char* lds, Seam& S) {
    int tid_ = threadIdx.x; asm volatile("" : "+v"(tid_));
    const int tid = tid_, wid = __builtin_amdgcn_readfirstlane(tid >> 6), lane = tid & 63, r32 = lane & 31, hi = lane >> 5;
    const int sr = tid >> 4, sc = (tid & 15) * 8, kws = KSWZ(sr, sc * 2); char* K_lds = lds + 2 * SHM_V;
#pragma unroll
    for (int d0 = 0; d0 < 8; ++d0) S.qr[d0] = load8(cur.Q + (size_t)(wid * QBLK + r32) * QS + d0 * 16 + hi * 8);
    SLOAD_H(cur.K, cur.V, 0); VMW(); SWRITE_HK(0);
    __syncthreads();
}
__device__ __forceinline__ void attn_block(const BlockRef& cur, const BlockRef& nxt, char* lds, Seam& S) {
    int tid_ = threadIdx.x; asm volatile("" : "+v"(tid_));
    const int tid = tid_, wid = __builtin_amdgcn_readfirstlane(tid >> 6), lane = tid & 63, r32 = lane & 31, hi = lane >> 5;
    const int NT = (cur.P0 + QB) / KVBLK;
    char* V_lds = lds; char* K_lds = lds + 2 * SHM_V;
    float* ws = (float*)(lds + 2 * SHM_V + 2 * SHM_K) + wid * 64; float* li_l = ws, * al_l = ws + 32;
    float m_reg = -1e30f, l_reg = 0; f32x16 o[4] = {};
    const int sr = tid >> 4, sc = (tid & 15) * 8, vst0 = v_st(sr, sc), vst1 = v_st(32 + sr, sc), kws = KSWZ(sr, sc * 2);
    const int vb0 = (int)(uintptr_t)V_lds + v_rd_base(lane);
    const bf16_t* Kh = cur.K; const bf16_t* Vh = cur.V;
    const cu64p mrow = cur.M + (size_t)wid * (32 * 32);
#define RESC(a) do { if (__any((a) < 1.f)) { if (hi == 0) al_l[r32] = (a); asm volatile("s_waitcnt lgkmcnt(0)" ::: "memory");              \
                     for (int d_ = 0; d_ < 4; ++d_) for (int r = 0; r < 16; ++r) o[d_][r] *= al_l[crow(r, hi)]; } } while (0)
#define KBASE(t) ((t) * KVBLK)
#define MASKT(P0_, P1_, t) mask_sel(P0_, P1_, mrow + (size_t)(t) * 32)
    constexpr int NQL = 8;
#define SEAM_K0() do { VMWN(NQL); SWRITE_HK(0); SBAR(); } while (0)
    f32x16 pA0, pA1, pB0, pB1; float mnA, mnB, alA, alB; bf16x8 pa0, pa1, pa2, pa3;
    SWRITE_HV(0); SBAR();
    if (NT > 1) { SLOAD_H(Kh, Vh, KBASE(1)); }
    SBAR(); qkt<0>(pA0, pA1, K_lds, r32, hi, S.qr);
    MASKT(pA0, pA1, 0); partialSM(pA0, pA1, m_reg, mnA, alA);
    if (NT > 1) { VMW(); SWRITE_H(1); }
    __syncthreads();
#define HALF_STEP(PX0, PX1, mnX, alX, PY0, PY1, alY, t, KB, VB, SB) do {                                                      \
        SBAR(); qkt<KB>(PX0, PX1, K_lds, r32, hi, S.qr);                                                         \
        finishSM(PY0, PY1, alY, l_reg, pa0, pa1, pa2, pa3); SBAR();                                                           \
        if ((t) + 1 < NT) { SLOAD_H(Kh, Vh, KBASE((t) + 1)); SBAR(); }                                               \
        pv_tile<VB>(o, vb0, pa0, pa1, pa2, pa3); MASKT(PX0, PX1, (t)); partialSM(PX0, PX1, m_reg, mnX, alX);                                        \
        __syncthreads();                                                                                                      \
        if ((t) + 1 < NT) { VMW(); SWRITE_H(SB); }                                                                          \
        RESC(alX); __syncthreads(); } while (0)
    for (int t = 1; t + 1 < NT; t += 2) {
        HALF_STEP(pB0, pB1, mnB, alB, pA0, pA1, alA, t, 1, 0, 0);
        HALF_STEP(pA0, pA1, mnA, alA, pB0, pB1, alB, t + 1, 0, 1, 1);
    }
    SBAR(); qkt<1>(pB0, pB1, K_lds, r32, hi, S.qr); SBAR();
    SLOAD_H(nxt.K, nxt.V, 0); SBAR();
#pragma unroll
    for (int d0 = 0; d0 < 8; ++d0) S.qr[d0] = load8(nxt.Q + (size_t)(wid * QBLK + r32) * QS + d0 * 16 + hi * 8);
    SBAR();
    finishSM(pA0, pA1, alA, l_reg, pa0, pa1, pa2, pa3); SBAR();
    pv_tile<0>(o, vb0, pa0, pa1, pa2, pa3);
    MASKT(pB0, pB1, NT - 1); partialSM(pB0, pB1, m_reg, mnB, alB); __syncthreads(); RESC(alB);
    finishSM(pB0, pB1, alB, l_reg, pa0, pa1, pa2, pa3); SBAR(); pv_tile<1>(o, vb0, pa0, pa1, pa2, pa3);
    SBAR(); SEAM_K0();
    if (hi == 0) li_l[r32] = l_reg; asm volatile("s_waitcnt lgkmcnt(0)" ::: "memory");
    float rli[16];
#pragma unroll
    for (int r = 0; r < 16; ++r) rli[r] = __builtin_amdgcn_rcpf(li_l[crow(r, hi)]);
    bf16_t* Ow = cur.O + (size_t)(wid * QBLK) * OS;
#pragma unroll
    for (int r = 0; r < 16; ++r) { const int orow = crow(r, hi);
#pragma unroll
        for (int d0 = 0; d0 < 4; ++d0) { const float v = o[d0][r] * rli[r];
            const float vn = __shfl_xor(v, 1);
            if ((r32 & 1) == 0) *(unsigned*)(Ow + (size_t)orow * OS + d0 * 32 + r32) = cvtpk(v, vn); } }
    __syncthreads();
#undef RESC
#undef KBASE
#undef MASKT
#undef SEAM_K0
#undef HALF_STEP
}
#undef ROW
#undef VMW
#undef VMWN
#undef SLOAD_H
#undef SWRITE_HK
#undef SWRITE_HV
#undef SWRITE_H
#undef KSWZ
#undef SBAR
}

#define XB_TMO      128
#define XB_XCNT(j)  (256  + 64 * (j))
#define XB_XSUB(j)  (1280 + 64 * (j))
#define XB_XGEN(j)  (2304 + 64 * (j))
#define XB_TOP      3328
#define XB_TOPGEN   3392
#define XCD_BAR_WORDS 3456
#define XB_SPIN_CAP (1u << 18)

__device__ __forceinline__ unsigned xb_ld(unsigned* p)              { return __hip_atomic_load(p, __ATOMIC_RELAXED, __HIP_MEMORY_SCOPE_AGENT); }
__device__ __forceinline__ unsigned xb_add(unsigned* p, unsigned v) { return __hip_atomic_fetch_add(p, v, __ATOMIC_RELAXED, __HIP_MEMORY_SCOPE_AGENT); }
__device__ __forceinline__ unsigned xb_xcc_id() { return (unsigned)__builtin_amdgcn_s_getreg((3 << 11) | 20) & 0xFu; }
#define XB_SPIN(cond, bar) do { unsigned _sp = 0; while (cond) { __builtin_amdgcn_s_sleep(1); \
    if ((++_sp & 255u) == 0u) { if (xb_ld(&(bar)[XB_TMO])) break; if (_sp > XB_SPIN_CAP) { atomicAdd(&(bar)[XB_TMO], 1u); break; } } } } while (0)

struct XcdBarrier {
    unsigned* bar; unsigned x;
    volatile LAS unsigned* st;
};

__device__ __forceinline__ XcdBarrier xcd_barrier_post(unsigned* bar, volatile LAS unsigned* st) {
    XcdBarrier b; b.bar = bar; b.x = xb_xcc_id(); b.st = st;
    if (threadIdx.x == 0) (void)xb_add(&bar[XB_XCNT(b.x)], 1u);
    return b;
}
__device__ __forceinline__ void xcd_barrier_complete(unsigned* bar, unsigned x, unsigned& nloc, unsigned& nx) {
    const unsigned G = gridDim.x * gridDim.y * gridDim.z;
    unsigned sum, cnt, mine, sp = 0u;
    for (;;) {
        sum = 0u; cnt = 0u; mine = 0u;
#pragma unroll
        for (unsigned j = 0; j < 16; ++j) { const unsigned c = xb_ld(&bar[XB_XCNT(j)]); sum += c; cnt += (c > 0u) ? 1u : 0u; mine = (j == x) ? c : mine; }
        if (sum == G) break;
        __builtin_amdgcn_s_sleep(1);
        if ((++sp & 255u) == 0u) { if (xb_ld(&bar[XB_TMO])) break; if (sp > XB_SPIN_CAP) { atomicAdd(&bar[XB_TMO], 1u); break; } }
    }
    nloc = mine > 0u ? mine : 1u; nx = cnt > 0u ? cnt : 1u;
}

__device__ __forceinline__ void xcd_barrier(const XcdBarrier& b) {
    asm volatile("s_waitcnt vmcnt(0)" ::: "memory");
    __syncthreads();
    if (threadIdx.x == 0) {
        unsigned* bar = b.bar;
        __builtin_amdgcn_s_waitcnt(0);
        unsigned nloc = b.st[0], nx = b.st[1];
        if (nloc == 0u) { xcd_barrier_complete(bar, b.x, nloc, nx); b.st[0] = nloc; b.st[1] = nx; }
        const unsigned old = xb_add(&bar[XB_XSUB(b.x)], 1u);
        const unsigned gen = old / nloc;
        if (old + 1u == (gen + 1u) * nloc) {
            __builtin_amdgcn_fence(__ATOMIC_RELEASE, "agent");
            asm volatile("s_waitcnt vmcnt(0)" ::: "memory");
            const unsigned og = xb_add(&bar[XB_TOP], 1u);
            const unsigned tg = og / nx;
            if (og + 1u == (tg + 1u) * nx) xb_add(&bar[XB_TOPGEN], 1u);
            else XB_SPIN(xb_ld(&bar[XB_TOPGEN]) == tg, bar);
            __builtin_amdgcn_fence(__ATOMIC_ACQUIRE, "agent");
            xb_add(&bar[XB_XGEN(b.x)], 1u);
            asm volatile("s_waitcnt vmcnt(0)" ::: "memory");
        } else {
            XB_SPIN(xb_ld(&bar[XB_XGEN(b.x)]) == gen, bar);
            __builtin_amdgcn_fence(__ATOMIC_ACQUIRE, "agent");
            asm volatile("s_waitcnt vmcnt(0)" ::: "memory");
        }
    }
    __syncthreads();
}

struct Args { const void* in[15]; float* out; unsigned char* ws; int ph_lo, ph_hi, li, pad; };
struct Frame {
    LAS unsigned char* lds;
    int tid, lane, wave, G;
    int gw, ngw;
};
__device__ __forceinline__ Frame mkframe(LAS unsigned char* lds) {
    Frame F; int t = threadIdx.x; asm volatile("" : "+v"(t));
    F.lds = lds; F.tid = t; F.lane = t & 63; F.wave = __builtin_amdgcn_readfirstlane(t >> 6);
    F.G = gridDim.x; F.gw = blockIdx.x * 8 + F.wave; F.ngw = F.G * 8; return F;
}
__device__ __forceinline__ const CAS Args* argp() { const CAS Args* p = (const CAS Args*)__builtin_amdgcn_kernarg_segment_ptr(); asm volatile("" : "+s"(p)); return p; }
#define ARG_F(ap, i) ((const float*)(ap)->in[i])
#define WS_AT(ap, T, off) ((T*)((ap)->ws + (off)))
enum { I_X = 0, I_C, I_POS, I_ADAW, I_ADAB, I_NORMG, I_FINALG, I_WGU, I_WD, I_PWIN, I_PWGRP, I_PSCALE, I_PWOUT, I_DWIN, I_DWOUT };

__device__ __forceinline__ void p0_ada_item(const Frame& F, int item) {
    const CAS Args* ap = argp(); const float* c_in = ARG_F(ap, I_C); const float* ada_w = ARG_F(ap, I_ADAW); const float* ada_b = ARG_F(ap, I_ADAB); float* ADA = WS_AT(ap, float, WS_ADA);
    LAS float* sc = (LAS float*)F.lds;
    LAS float* red = sc + 4 * DM;
    for (int i = F.tid; i < 4 * DM; i += 512) { const float v = c_in[i]; sc[i] = v / (1.f + __expf(-v)); }
    __syncthreads();
    const int l = item / 72, chunk = item % 72, e0 = chunk * 256 + 4 * F.lane;
    const float* wp = ada_w + ((size_t)l * DM + (size_t)F.wave * 256) * ADA_E + e0;
    f32x4 a0 = {0.f, 0.f, 0.f, 0.f}, a1 = a0, a2 = a0, a3 = a0;
    const LAS float* s0 = sc + F.wave * 256;
#pragma unroll 8
    for (int d = 0; d < 256; ++d) { const f32x4 xv = *(const f32x4*)(wp + (size_t)d * ADA_E);
        a0 += xv * s0[d]; a1 += xv * s0[DM + d]; a2 += xv * s0[2 * DM + d]; a3 += xv * s0[3 * DM + d]; }
    LAS f32x4* rp = (LAS f32x4*)(red + (F.wave * 4) * 256) + F.lane;
    rp[0] = a0; rp[64] = a1; rp[128] = a2; rp[192] = a3;
    __syncthreads();
#pragma unroll
    for (int i = 0; i < 2; ++i) { const int o = F.tid + 512 * i, b = o >> 8, col = o & 255; float s = 0.f;
#pragma unroll
        for (int w = 0; w < 8; ++w) s += red[(w * 4 + b) * 256 + col];
        const int e = chunk * 256 + col;
        ADA[(size_t)(b * 2 + l) * ADA_E + e] = s + ada_b[l * ADA_E + e]; }
    __syncthreads();
}
__device__ __forceinline__ int cvt_pos(int perm, int n) {
    if (perm == 1) return n < 16 ? 2 * n : (n < 32 ? 2 * (n - 16) + 1 : n);
    if (perm == 2) return n < 8 ? 2 * n : (n < 16 ? 2 * (n - 8) + 1 : n);
    return n;
}
__device__ __forceinline__ void cvt_item(const float* W, int Nsrc, int k0, int c0, int nvalid, bf16_t* Bt, int ldb, int drow0, int perm, const float* rscale, LAS unsigned* scr, int lane) {
    const int gq = lane >> 4, q = lane & 15;
    const bool valid = 4 * q < nvalid;
    f32x4 va[8], vb[8];
#pragma unroll
    for (int i = 0; i < 8; ++i) { const int k = k0 + 8 * i + 2 * gq; const float* p = W + (size_t)k * Nsrc + c0 + 4 * q;
        va[i] = valid ? *(const f32x4*)p : (f32x4){0.f, 0.f, 0.f, 0.f}; vb[i] = valid ? *(const f32x4*)(p + Nsrc) : (f32x4){0.f, 0.f, 0.f, 0.f}; }
    int prow[4];
#pragma unroll
    for (int e = 0; e < 4; ++e) prow[e] = cvt_pos(perm, 4 * q + e) * 33;
#pragma unroll
    for (int i = 0; i < 8; ++i) { const int k = k0 + 8 * i + 2 * gq; float sa = 1.f, sb = 1.f;
        if (rscale) { sa = rscale[k]; sb = rscale[k + 1]; }
#pragma unroll
        for (int e = 0; e < 4; ++e) scr[prow[e] + 4 * i + gq] = cvt_pk_bf16(va[i][e] * sa, vb[i][e] * sb); }
    LDS_WAIT(); asm volatile("" ::: "memory");
    const int c = lane & 7;
#pragma unroll
    for (int jj = 0; jj < 8; ++jj) { const int n = (lane >> 3) + 8 * jj; const LAS unsigned* s = scr + n * 33 + 4 * c;
        u32x4 o; o.x = s[0]; o.y = s[1]; o.z = s[2]; o.w = s[3];
        *(u32x4*)(Bt + (size_t)(drow0 + n) * ldb + k0 + 8 * c) = o; }
    LDS_WAIT(); asm volatile("" ::: "memory");
}
constexpr int CV_WGU = 4 * 32 * 176, CV_WD = 4 * 88 * 32, CV_PWIN = 32 * 32, CV_PWGRP = 4 * 8 * 8, CV_PWOUT = 32 * 32, CV_DWIN = 32 * 66, CV_DWOUT = 32 * 32;
constexpr int CV_TOTAL = CV_WGU + CV_WD + CV_PWIN + CV_PWGRP + CV_PWOUT + CV_DWIN + CV_DWOUT;
__device__ __forceinline__ void p0_cvt_dispatch(int it, LAS unsigned* scr, int lane) {
    const CAS Args* ap = argp(); int r = it;
    if (r < CV_WGU) { const int mat = r / (32 * 176); r -= mat * (32 * 176); const int nb = r / 32, kb = r % 32, c0 = 64 * nb;
        const int is_u = c0 >= FF ? 1 : 0, hid = c0 - is_u * FF, drow = 256 * (hid >> 7) + 128 * is_u + (hid & 127);
        cvt_item(ARG_F(ap, I_WGU) + (size_t)mat * DM * 2 * FF, 2 * FF, 64 * kb, c0, 64, WS_AT(ap, bf16_t, WS_WGU) + (size_t)mat * 2 * FF * DM, DM, drow, 0, nullptr, scr, lane); return; }
    r -= CV_WGU;
    if (r < CV_WD) { const int mat = r / (88 * 32); r -= mat * (88 * 32); const int nb = r / 88, kb = r % 88;
        cvt_item(ARG_F(ap, I_WD) + (size_t)mat * FF * DM, DM, 64 * kb, 64 * nb, 64, WS_AT(ap, bf16_t, WS_WD) + (size_t)mat * DM * FF, FF, 64 * nb, 0, nullptr, scr, lane); return; }
    r -= CV_WD;
    if (r < CV_PWIN) { const int nb = r / 32, kb = r % 32; cvt_item(ARG_F(ap, I_PWIN), DM, 64 * kb, 64 * nb, 64, WS_AT(ap, bf16_t, WS_PWIN), DM, 64 * nb, 0, nullptr, scr, lane); return; }
    r -= CV_PWIN;
    if (r < CV_PWGRP) { const int g = r / 64; r -= g * 64; const int nb = r / 8, kb = r % 8;
        cvt_item(ARG_F(ap, I_PWGRP) + (size_t)g * 512 * 512, 512, 64 * kb, 64 * nb, 64, WS_AT(ap, bf16_t, WS_PWGRP), 512, g * 512 + 64 * nb, 0, nullptr, scr, lane); return; }
    r -= CV_PWGRP;
    if (r < CV_PWOUT) { const int nb = r / 32, kb = r % 32; cvt_item(ARG_F(ap, I_PWOUT), DM, 64 * kb, 64 * nb, 64, WS_AT(ap, bf16_t, WS_PWOUT), DM, 64 * nb, 0, ARG_F(ap, I_PSCALE), scr, lane); return; }
    r -= CV_PWOUT;
    if (r < CV_DWIN) { const int nb = r / 32, kb = r % 32, c0 = 64 * nb; int perm = 0, nvalid = 64;
        if (c0 < 2560) perm = ((c0 & 127) == 0) ? 1 : 0; else if (c0 < 3072) perm = 0; else if (c0 < 4160) perm = 2; else { perm = 0; nvalid = 16; }
        cvt_item(ARG_F(ap, I_DWIN), DSA_IN, 64 * kb, c0, nvalid, WS_AT(ap, bf16_t, WS_DWIN), DM, c0, perm, nullptr, scr, lane); return; }
    r -= CV_DWIN;
    { const int nb = r / 32, kb = r % 32; cvt_item(ARG_F(ap, I_DWOUT), DM, 64 * kb, 64 * nb, 64, WS_AT(ap, bf16_t, WS_DWOUT), DM, 64 * nb, 0, nullptr, scr, lane); }
}
__device__ __forceinline__ void p0_prologue(const Frame& F) {
    for (int it = blockIdx.x; it < 144; it += F.G) p0_ada_item(F, it);
    { const CAS Args* ap = argp(); const int* pos = (const int*)ap->in[I_POS]; float* cosq = WS_AT(ap, float, WS_COSQ); float* sinq = WS_AT(ap, float, WS_SINQ); float* cosi = WS_AT(ap, float, WS_COSI); float* sini = WS_AT(ap, float, WS_SINI);
    for (int row = F.gw; row < NTOK; row += F.ngw) {
        if (F.lane < 24) { const float p = (float)pos[row]; const bool isq = F.lane < 16; const int i = isq ? F.lane : F.lane - 16;
            float sn, cs; sincos_acc(p * (isq ? INVF_Q[i] : INVF_I[i]), sn, cs);
            if (isq) { cosq[(size_t)row * 16 + i] = cs; sinq[(size_t)row * 16 + i] = sn; } else { cosi[(size_t)row * 8 + i] = cs; sini[(size_t)row * 8 + i] = sn; } }
    } }
    { const size_t n16 = (size_t)(DSA_NPAD - 4224) * DM * 2 / 16; u32x4* zp = (u32x4*)(WS_AT(argp(), bf16_t, WS_DWIN) + (size_t)4224 * DM);
      for (size_t i = (size_t)blockIdx.x * 512 + F.tid; i < n16; i += (size_t)F.G * 512) zp[i] = (u32x4){0u, 0u, 0u, 0u}; }
    __syncthreads();
    LAS unsigned* scr = (LAS unsigned*)(F.lds + F.wave * 8704);
    for (;;) {
        int it = 0; if (F.lane == 0) it = (int)__hip_atomic_fetch_add(WS_AT(argp(), unsigned, WS_CTL) + CW_QUEUE, 1u, RLX_AGENT);
        it = __builtin_amdgcn_readfirstlane(it);
        if (it >= CV_TOTAL) break;
        p0_cvt_dispatch(it, scr, F.lane);
    }
}

__device__ __forceinline__ void norm_phase(const Frame& F, const float* src, float* cpy, const float* g, const float* mod0  , bf16_t* Y) {
    for (int r0 = 4 * F.gw; r0 < NTOK; r0 += 4 * F.ngw) {
        const int b = r0 / SEQ; const float* mod = mod0 + (size_t)b * 2 * ADA_E;
        f32x4 A[8], Bv[8];
#pragma unroll
        for (int j = 0; j < 8; ++j) { const int col = 4 * F.lane + 256 * j; const f32x4 gv = *(const f32x4*)(g + col), sc = *(const f32x4*)(mod + DM + col);
            A[j] = gv * (sc + 1.0f); Bv[j] = *(const f32x4*)(mod + col); }
        for (int rr = 0; rr < 4; ++rr) { const int row = r0 + rr; const f32x4* xr = (const f32x4*)(src + (size_t)row * DM) + F.lane;
            f32x4 v[8]; float s = 0.f;
#pragma unroll
            for (int j = 0; j < 8; ++j) { v[j] = xr[64 * j]; s += (v[j].x * v[j].x + v[j].y * v[j].y) + (v[j].z * v[j].z + v[j].w * v[j].w); }
            const float rstd = 1.0f / sqrtf(wave_sum(s) * (1.0f / DM) + RMS_EPS);
            if (cpy) { f32x4* cr = (f32x4*)(cpy + (size_t)row * DM) + F.lane;
#pragma unroll
                for (int j = 0; j < 8; ++j) cr[64 * j] = v[j]; }
            u32x2* yr = (u32x2*)(Y + (size_t)row * DM) + F.lane;
#pragma unroll
            for (int j = 0; j < 8; ++j) { const f32x4 o = v[j] * rstd * A[j] + Bv[j]; u32x2 w; w.x = cvt_pk_bf16(o.x, o.y); w.y = cvt_pk_bf16(o.z, o.w); yr[64 * j] = w; } }
    }
}
__device__ __forceinline__ void final_norm_phase(const Frame& F, float* H, const float* g) {
    for (int row = F.gw; row < NTOK; row += F.ngw) { f32x4* xr = (f32x4*)(H + (size_t)row * DM) + F.lane;
        f32x4 v[8]; float s = 0.f;
#pragma unroll
        for (int j = 0; j < 8; ++j) { v[j] = xr[64 * j]; s += (v[j].x * v[j].x + v[j].y * v[j].y) + (v[j].z * v[j].z + v[j].w * v[j].w); }
        const float rstd = 1.0f / sqrtf(wave_sum(s) * (1.0f / DM) + RMS_EPS);
#pragma unroll
        for (int j = 0; j < 8; ++j) xr[64 * j] = v[j] * rstd * *(const f32x4*)(g + 4 * F.lane + 256 * j); }
}
__device__ __forceinline__ void pool_phase(const Frame& F, const bf16_t* U, bf16_t* Pp) {
    for (int task = F.gw; task < NB * 4 * (SEQ / 16); task += F.ngw) {
        const int run = task % (SEQ / 16), g = (task / (SEQ / 16)) & 3, b = task / (4 * (SEQ / 16));
        const int w = 2 << g, t0 = run * 16;
        const bf16_t* ub = U + (size_t)b * SEQ * DM + 512 * g + 8 * F.lane; bf16_t* pb = Pp + (size_t)b * SEQ * DM + 512 * g + 8 * F.lane;
        float s[8];
#pragma unroll
        for (int e = 0; e < 8; ++e) s[e] = 0.f;
        for (int j = (t0 - w + 1 > 0 ? t0 - w + 1 : 0); j < t0; ++j) { const u32x4 x = *(const u32x4*)(ub + (size_t)j * DM);
            s[0] += bf_lo(x.x); s[1] += bf_hi(x.x); s[2] += bf_lo(x.y); s[3] += bf_hi(x.y); s[4] += bf_lo(x.z); s[5] += bf_hi(x.z); s[6] += bf_lo(x.w); s[7] += bf_hi(x.w); }
#pragma unroll 4
        for (int t = t0; t < t0 + 16; ++t) { const u32x4 x = *(const u32x4*)(ub + (size_t)t * DM);
            float u[8] = {bf_lo(x.x), bf_hi(x.x), bf_lo(x.y), bf_hi(x.y), bf_lo(x.z), bf_hi(x.z), bf_lo(x.w), bf_hi(x.w)};
            if (t > t0 && t - w >= 0) { const u32x4 y = *(const u32x4*)(ub + (size_t)(t - w) * DM);
                s[0] -= bf_lo(y.x); s[1] -= bf_hi(y.x); s[2] -= bf_lo(y.y); s[3] -= bf_hi(y.y); s[4] -= bf_lo(y.z); s[5] -= bf_hi(y.z); s[6] -= bf_lo(y.w); s[7] -= bf_hi(y.w); }
            const float inv = 1.0f / (float)((t + 1) < w ? (t + 1) : w);
            float o[8];
#pragma unroll
            for (int e = 0; e < 8; ++e) { s[e] += u[e]; o[e] = s[e] * inv - u[e]; }
            u32x4 wv; wv.x = cvt_pk_bf16(o[0], o[1]); wv.y = cvt_pk_bf16(o[2], o[3]); wv.z = cvt_pk_bf16(o[4], o[5]); wv.w = cvt_pk_bf16(o[6], o[7]);
            *(u32x4*)(pb + (size_t)t * DM) = wv; }
    }
}
__device__ __forceinline__ void dk_phase(const Frame& F) {
    const CAS Args* ap = argp(); const float* KWP = WS_AT(ap, float, WS_BIG + BIG_KWP); const float* cosi = WS_AT(ap, float, WS_COSI); const float* sini = WS_AT(ap, float, WS_SINI);
    bf16_t* KI = WS_AT(ap, bf16_t, WS_KI); float* WI = WS_AT(ap, float, WS_WI);
    const int nthr = F.G * 512;
    for (int i = blockIdx.x * 512 + F.tid; i < NTOK * 20; i += nthr) { const int row = i / 20, q = i % 20;
        f32x4 s = {0.f, 0.f, 0.f, 0.f};
#pragma unroll
        for (int k = 0; k < 8; ++k) s += *(const f32x4*)(KWP + ((size_t)k * NTOK + row) * 128 + 4 * q);
        if (q < 16) {
            if (q < 4) { const float c0 = cosi[(size_t)row * 8 + 2 * q], s0 = sini[(size_t)row * 8 + 2 * q], c1 = cosi[(size_t)row * 8 + 2 * q + 1], s1 = sini[(size_t)row * 8 + 2 * q + 1];
                const f32x4 a = s; s.x = a.x * c0 - a.y * s0; s.y = a.y * c0 + a.x * s0; s.z = a.z * c1 - a.w * s1; s.w = a.w * c1 + a.z * s1; }
            u32x2 w; w.x = cvt_pk_bf16(s.x, s.y); w.y = cvt_pk_bf16(s.z, s.w); *(u32x2*)(KI + (size_t)row * 64 + 4 * q) = w;
        } else *(f32x4*)(WI + (size_t)row * 16 + 4 * (q - 16)) = s;
    }
}

constexpr int MN_PITCH = 65;
constexpr int MN_OFF = RING_BYTES + 1024;
static_assert(MN_OFF + 32 * MN_PITCH * 4 <= LDS_BYTES, "LDS map: select phase");
__device__ __forceinline__ void select_unit(const Frame& F, int b, int grp) {
    const CAS Args* ap = argp(); const bf16_t* QI = WS_AT(ap, bf16_t, WS_BIG + BIG_QI); const bf16_t* KI = WS_AT(ap, bf16_t, WS_KI); const float* WI = WS_AT(ap, float, WS_WI);
    LAS unsigned* MN = (LAS unsigned*)(F.lds + MN_OFF);
    const int lane = F.lane, half = lane >> 5, l31 = lane & 31;
    LAS float* SC = (LAS float*)F.lds + (F.wave * 2 + half) * SEQ + l31;
#pragma unroll 1
    for (int round = 0; round < 2; ++round) {
        const int tok0 = 32 * grp + 16 * round + 2 * F.wave, myt = tok0 + half;
        const int ntile = ((tok0 + 1) >> 5) + 1;
        {
            const int at = (l31 >> 2) & 1, ah = (l31 & 3) + 4 * (l31 >> 3);
            const bf16_t* qp = QI + (size_t)(b * SEQ + tok0 + at) * 1024 + ah * 64 + 8 * half;
            bf16x8 af[4];
#pragma unroll
            for (int s = 0; s < 4; ++s) af[s] = *(const bf16x8*)(qp + 16 * s);
            float wv[16];
            { const f32x4* wp = (const f32x4*)(WI + (size_t)(b * SEQ + myt) * 16);
#pragma unroll
              for (int i = 0; i < 4; ++i) { const f32x4 x = wp[i]; wv[4 * i] = x.x; wv[4 * i + 1] = x.y; wv[4 * i + 2] = x.z; wv[4 * i + 3] = x.w; } }
            const bf16_t* kp = KI + (size_t)(b * SEQ + l31) * 64 + 8 * half;
#pragma unroll 2
            for (int tile = 0; tile < ntile; ++tile) {
                f32x16 acc = {};
#pragma unroll
                for (int s = 0; s < 4; ++s) { const bf16x8 bfr = *(const bf16x8*)(kp + (size_t)tile * 32 * 64 + 16 * s); acc = __builtin_amdgcn_mfma_f32_32x32x16_bf16(af[s], bfr, acc, 0, 0, 0); }
                float t = 0.f;
#pragma unroll
                for (int i = 0; i < 16; ++i) t += wv[i] * fmaxf(acc[i], 0.f);
                SC[32 * tile] = (32 * tile + l31 <= myt) ? t : -__builtin_inff();
            }
        }
        LDS_WAIT(); asm volatile("" ::: "memory");
        float v[64];
#pragma unroll
        for (int i = 0; i < 64; ++i) { const float x = SC[32 * i]; v[i] = (i < ntile) ? x : -__builtin_inff(); }
        float thr = -3.0e38f;
        {
            float mn = 3.0e38f, mx = -3.0e38f;
#pragma unroll
            for (int i = 0; i < 64; ++i) { mx = fmaxf(mx, v[i]); mn = fminf(mn, v[i] == -__builtin_inff() ? 3.0e38f : v[i]); }
#pragma unroll
            for (int o = 1; o < 32; o <<= 1) { mx = fmaxf(mx, __shfl_xor(mx, o)); mn = fminf(mn, __shfl_xor(mn, o)); }
            float lo = mn, hi = mx + fabsf(mx) * 1e-6f + 1e-30f;
            bool done = (myt + 1 <= TOPK);
#pragma unroll 1
            for (int it = 0; it < 64; ++it) {
                if (__all(done)) break;
                const float mid = 0.5f * (lo + hi);
                int c = 0;
#pragma unroll
                for (int i = 0; i < 64; ++i) c += (v[i] >= mid) ? 1 : 0;
#pragma unroll
                for (int o = 1; o < 32; o <<= 1) c += __shfl_xor(c, o);
                if (!done) {
                    if (!(mid > lo && mid < hi)) done = true;
                    else if (c >= TOPK) { lo = mid; if (c == TOPK) done = true; }
                    else hi = mid;
                }
            }
            if (myt + 1 > TOPK) thr = lo;
        }
        unsigned m0 = 0u, m1 = 0u;
#pragma unroll
        for (int i = 0; i < 64; ++i) { const unsigned long long bal = __ballot(v[i] >= thr);
            if (lane == i) { m0 = (unsigned)bal; m1 = (unsigned)(bal >> 32); }
            if ((i & 3) == 3) __builtin_amdgcn_sched_barrier(0); }
        const int trow = 16 * round + 2 * F.wave;
        MN[trow * MN_PITCH + lane] = m0; MN[(trow + 1) * MN_PITCH + lane] = m1;
    }
    __syncthreads();
    unsigned long long* mout = WS_AT(ap, unsigned long long, WS_MASK) + (size_t)((b * 64 + grp) * 32) * 32;
#pragma unroll 1
    for (int j = F.wave; j < 32; j += 8) {
        const unsigned d0 = MN[l31 * MN_PITCH + 2 * j], d1 = MN[l31 * MN_PITCH + 2 * j + 1];
        unsigned wlo = 0u, whi = 0u;
#pragma unroll
        for (int r = 0; r < 16; ++r) { const int cc = (r & 3) + 8 * (r >> 2);
            const unsigned long long b0 = __ballot(((d0 >> (cc + 4 * half)) & 1u) != 0u), b1 = __ballot(((d1 >> (cc + 4 * half)) & 1u) != 0u);
            if (lane == r) { wlo = (unsigned)b0; whi = (unsigned)(b0 >> 32); }
            if (lane == 16 + r) { wlo = (unsigned)b1; whi = (unsigned)(b1 >> 32); }
            if ((r & 1) == 1) __builtin_amdgcn_sched_barrier(0); }
        if (lane < 32) mout[(size_t)j * 32 + lane] = ((unsigned long long)whi << 32) | wlo;
    }
    __syncthreads();
}

constexpr int N_PHASES = 25;
#ifndef MK_KINDS
#define MK_KINDS 0xffff
#endif
#define HAVE(k) (((MK_KINDS) >> (k)) & 1)

__global__ void __launch_bounds__(NWAVES * 64, 2) mk_fwd(Args args) {
    extern __shared__ __attribute__((aligned(16))) unsigned char lds[];
    LAS unsigned char* const ldsp = (LAS unsigned char*)lds;
    for (int u = threadIdx.x; u < (LDS_BYTES - LDSCTL_OFF) / 4; u += NWAVES * 64) ((LAS unsigned*)(ldsp + LDSCTL_OFF))[u] = 0u;
    __syncthreads();
    XcdBarrier bar = xcd_barrier_post((unsigned*)(args.ws + WS_CTL) + CW_BAR + args.li * XCD_BAR_WORDS, (volatile LAS unsigned*)(ldsp + MISC_OFF) + 8);
    const int NG = gridDim.x;

    const int lo = args.ph_lo, hi = args.ph_hi;
    int ph = 0;
#define IN_PH() (lo <= ph && ph < hi)
#define SEAM() do { if (lo <= ph && ph + 1 < hi) xcd_barrier(bar); ++ph; } while (0)
    const int bx = (int)blockIdx.x;
    constexpr long TILE_A = 256L * DM * 2;
#define ADA_AT(ap, l, sub, k) (WS_AT(ap, float, WS_ADA) + (size_t)(l) * ADA_E + ((sub) * 3 + (k)) * DM)

    if (HAVE(0) && IN_PH()) { const Frame F = mkframe(ldsp); p0_prologue(F); }
    SEAM();
#pragma unroll 1
    for (int l = 0; l < 2; ++l) {
#pragma unroll 1
        for (int f = 0; f < 2; ++f) {
            if (f == 1) {
                if (HAVE(1) && IN_PH()) { const CAS Args* ap = argp();
                    const Frame F = mkframe(ldsp); norm_phase(F, ap->out, nullptr, ARG_F(ap, I_NORMG) + (size_t)(l * 3 + 1) * DM, ADA_AT(ap, l, 1, 0), WS_AT(ap, bf16_t, WS_Y)); }
                SEAM();
                if (l == 0) {
                    if (HAVE(4) && IN_PH()) { const CAS Args* ap = argp(); pg8::Gemm g{WS_AT(ap, bf16_t, WS_Y), WS_AT(ap, bf16_t, WS_PWIN), DM, DM, DM}; pg8::StaticOrder S; S.init(32, 8, NG, bx, TILE_A, 0, 0, TILE_A);
                        pg8::EpiBf16 E{WS_AT(ap, bf16_t, WS_BIG + BIG_U), DM}; pg8::gemm_phase<pg8::EpiBf16, pg8::StaticOrder, true, true>(ldsp, g, S, E); }
                    SEAM();
                    if (HAVE(5) && IN_PH()) { const CAS Args* ap = argp(); const Frame F = mkframe(ldsp); pool_phase(F, WS_AT(ap, bf16_t, WS_BIG + BIG_U), WS_AT(ap, bf16_t, WS_BIG + BIG_P)); }
                    SEAM();
                    if (HAVE(6) && IN_PH()) { const CAS Args* ap = argp(); pg8::Gemm g{WS_AT(ap, bf16_t, WS_BIG + BIG_P), WS_AT(ap, bf16_t, WS_PWGRP), DM, 512, 512}; pg8::StaticOrder S; S.init(32, 8, NG, bx, TILE_A, 1, 512 * 2, 256L * 512 * 2);
                        pg8::EpiBf16 E{WS_AT(ap, bf16_t, WS_BIG + BIG_V), DM}; pg8::gemm_phase<pg8::EpiBf16, pg8::StaticOrder, true, true>(ldsp, g, S, E); }
                    SEAM();
                    if (HAVE(7) && IN_PH()) { const CAS Args* ap = argp(); pg8::Gemm g{WS_AT(ap, bf16_t, WS_BIG + BIG_V), WS_AT(ap, bf16_t, WS_PWOUT), DM, DM, DM}; pg8::StaticOrder S; S.init(32, 8, NG, bx, TILE_A, 0, 0, TILE_A);
                        pg8::EpiResid E{ap->out, ADA_AT(ap, l, 1, 2), 1.0f}; pg8::gemm_phase<pg8::EpiResid, pg8::StaticOrder, true, true>(ldsp, g, S, E); }
                    SEAM();
                } else {
                    if (HAVE(8) && IN_PH()) {
                        { const CAS Args* ap = argp(); pg8::Gemm g{WS_AT(ap, bf16_t, WS_Y), WS_AT(ap, bf16_t, WS_DWIN), DM, DM, DM}; pg8::StaticOrder S; S.init(32, 16, NG, bx, TILE_A, 0, 0, TILE_A);
                          pg8::EpiDsaIn E{WS_AT(ap, bf16_t, WS_BIG + BIG_Q), WS_AT(ap, bf16_t, WS_BIG + BIG_K), WS_AT(ap, bf16_t, WS_BIG + BIG_VV), WS_AT(ap, bf16_t, WS_BIG + BIG_QI),
                                              WS_AT(ap, float, WS_COSQ), WS_AT(ap, float, WS_SINQ), WS_AT(ap, float, WS_COSI), WS_AT(ap, float, WS_SINI)};
                          pg8::gemm_phase<pg8::EpiDsaIn, pg8::StaticOrder, true, true>(ldsp, g, S, E); }
                        __syncthreads();
                        { const CAS Args* ap = argp(); pg8::Gemm g{WS_AT(ap, bf16_t, WS_Y), WS_AT(ap, bf16_t, WS_DWIN) + (size_t)4096 * DM, DM, DM, 256}; pg8::StaticOrder S; S.init(32, 8, NG, bx, TILE_A, 0, 256 * 2, 256 * 2);
                          pg8::EpiKW E{WS_AT(ap, float, WS_BIG + BIG_KWP)}; pg8::gemm_phase<pg8::EpiKW, pg8::StaticOrder, true, true>(ldsp, g, S, E); }
                    }
                    SEAM();
                    if (HAVE(9) && IN_PH()) { const Frame F = mkframe(ldsp); dk_phase(F); }
                    SEAM();
                    if (HAVE(10) && IN_PH()) { for (int u = bx; u < NB * 64; u += NG) { const Frame F = mkframe(ldsp); select_unit(F, u >> 6, u & 63); } }
                    SEAM();
                    if (HAVE(11) && IN_PH()) {
                        for (int L = bx; L < 256; L += NG) {
                            const CAS Args* ap = argp();
                            const bf16_t* Qp = WS_AT(ap, bf16_t, WS_BIG + BIG_Q); const bf16_t* Kp = WS_AT(ap, bf16_t, WS_BIG + BIG_K); const bf16_t* Vp = WS_AT(ap, bf16_t, WS_BIG + BIG_VV);
                            bf16_t* Op = WS_AT(ap, bf16_t, WS_O); const unsigned long long* Mp = WS_AT(ap, unsigned long long, WS_MASK);
                            const int xcd = L & 7, k = L >> 3, kvg = 2 * xcd + (k >> 4), r = k & 15, b = kvg >> 2, gk = kvg & 3, h = 4 * gk + (r >> 2), pr = r & 3;
                            attn::BlockRef cur, nxt;
                            { const int qb = pr; const size_t row0 = (size_t)b * SEQ + (size_t)qb * 256;
                              cur.Q = Qp + row0 * DM + h * 128; cur.O = Op + row0 * DM + h * 128; cur.K = Kp + (size_t)b * SEQ * 512 + gk * 128; cur.V = Vp + (size_t)b * SEQ * 512 + gk * 128;
                              cur.M = (attn::cu64p)(Mp + (size_t)((b * 64 + qb * 8) * 32) * 32); cur.P0 = qb * 256; }
                            { const int qb = 7 - pr; const size_t row0 = (size_t)b * SEQ + (size_t)qb * 256;
                              nxt.Q = Qp + row0 * DM + h * 128; nxt.O = Op + row0 * DM + h * 128; nxt.K = cur.K; nxt.V = cur.V;
                              nxt.M = (attn::cu64p)(Mp + (size_t)((b * 64 + qb * 8) * 32) * 32); nxt.P0 = qb * 256; }
                            attn::Seam S;
                            attn::attn_prime(cur, (char*)lds, S);
#pragma unroll 1
                            for (int i = 0; i < 2; ++i) { attn::attn_block(cur, nxt, (char*)lds, S); cur = nxt; }
                        }
                    }
                    SEAM();
                    if (HAVE(12) && IN_PH()) { const CAS Args* ap = argp(); pg8::Gemm g{WS_AT(ap, bf16_t, WS_O), WS_AT(ap, bf16_t, WS_DWOUT), DM, DM, DM}; pg8::StaticOrder S; S.init(32, 8, NG, bx, TILE_A, 0, 0, TILE_A);
                        pg8::EpiResid E{ap->out, ADA_AT(ap, l, 1, 2), 1.0f}; pg8::gemm_phase<pg8::EpiResid, pg8::StaticOrder, true, true>(ldsp, g, S, E); }
                    SEAM();
                }
            }
            const int sub = f == 0 ? 0 : 2;
            if (HAVE(1) && IN_PH()) { const CAS Args* ap = argp(); const bool first = (l == 0 && f == 0); const Frame F = mkframe(ldsp);
                norm_phase(F, first ? ARG_F(ap, I_X) : (const float*)ap->out, first ? ap->out : nullptr, ARG_F(ap, I_NORMG) + (size_t)(l * 3 + sub) * DM, ADA_AT(ap, l, sub, 0), WS_AT(ap, bf16_t, WS_Y)); }
            SEAM();
            if (HAVE(2) && IN_PH()) { const CAS Args* ap = argp(); pg8::Gemm g{WS_AT(ap, bf16_t, WS_Y), WS_AT(ap, bf16_t, WS_WGU) + (size_t)(l * 2 + f) * 2 * FF * DM, DM, DM, DM}; pg8::StaticOrder S; S.init(32, 44, NG, bx, TILE_A, 0, 0, TILE_A);
                pg8::EpiSwiglu E{WS_AT(ap, bf16_t, WS_BIG), FF}; pg8::gemm_phase<pg8::EpiSwiglu, pg8::StaticOrder, true, true>(ldsp, g, S, E); }
            SEAM();
            if (HAVE(3) && IN_PH()) { const CAS Args* ap = argp(); pg8::Gemm g{WS_AT(ap, bf16_t, WS_BIG), WS_AT(ap, bf16_t, WS_WD) + (size_t)(l * 2 + f) * DM * FF, FF, FF, FF}; pg8::StaticOrder S; S.init(32, 8, NG, bx, 256L * FF * 2, 0, 0, 256L * FF * 2);
                pg8::EpiResid E{ap->out, ADA_AT(ap, l, sub, 2), 0.5f}; pg8::gemm_phase<pg8::EpiResid, pg8::StaticOrder, true, true>(ldsp, g, S, E); }
            SEAM();
        }
    }
    if (HAVE(13) && IN_PH()) { const CAS Args* ap = argp(); const Frame F = mkframe(ldsp); final_norm_phase(F, ap->out, ARG_F(ap, I_FINALG)); }
#undef IN_PH
#undef SEAM
}

extern "C" void kernel_launch(void* const* d_in, const int* in_sizes, int n_in, void* d_out, int out_size, void* d_ws, size_t ws_size, hipStream_t stream) {
    static int grid = 0;
    if (grid == 0) {
        if (n_in != 15 || out_size != NTOK * DM || ws_size < WS_END) { fprintf(stderr, "kernel_launch: unexpected shapes (n_in %d, out %d, ws %zu)\n", n_in, out_size, ws_size); grid = -1; return; }
        int dev = 0, cus = 0, per_cu = 0;
        if (hipGetDevice(&dev) != hipSuccess || hipDeviceGetAttribute(&cus, hipDeviceAttributeMultiprocessorCount, dev) != hipSuccess) { grid = -1; return; }
        if (hipFuncSetAttribute((const void*)mk_fwd, hipFuncAttributeMaxDynamicSharedMemorySize, LDS_BYTES) != hipSuccess) { fprintf(stderr, "kernel_launch: hipFuncSetAttribute failed\n"); grid = -1; return; }
        if (hipOccupancyMaxActiveBlocksPerMultiprocessor(&per_cu, (const void*)mk_fwd, NWAVES * 64, LDS_BYTES) != hipSuccess || per_cu < 1) { fprintf(stderr, "kernel_launch: occupancy query says %d\n", per_cu); }
        (void)hipGetLastError();
        grid = cus;
    }
    if (grid < 0) return;
    (void)in_sizes;
    if (hipMemsetAsync((char*)d_ws + WS_CTL, 0, CTL_ZERO_BYTES, stream) != hipSuccess) return;
    Args a{};
    for (int i = 0; i < 15; ++i) a.in[i] = d_in[i];
    a.out = (float*)d_out; a.ws = (unsigned char*)d_ws;
#if MK_N_LAUNCHES == 1
    a.ph_lo = 0; a.ph_hi = N_PHASES; a.li = 0; a.pad = 0;
    hipLaunchKernelGGL(mk_fwd, dim3(grid), dim3(NWAVES * 64), LDS_BYTES, stream, a);
#else
    for (int p = 0; p < N_PHASES; ++p) { a.ph_lo = p; a.ph_hi = p + 1; a.li = 0; a.pad = 0;
        hipLaunchKernelGGL(mk_fwd, dim3(grid), dim3(NWAVES * 64), LDS_BYTES, stream, a); }
#endif
}
```

```cpp
#include <hip/hip_runtime.h>
#include <cstdio>
#include <cstdint>
#ifndef MK_N_LAUNCHES
#define MK_N_LAUNCHES 1
#endif

#define LAS __attribute__((address_space(3)))
#define GAS __attribute__((address_space(1)))
#define CAS __attribute__((address_space(4)))
typedef unsigned short bf16_t;
typedef short bf16x8 __attribute__((ext_vector_type(8)));
typedef short s16x4 __attribute__((ext_vector_type(4)));
typedef float f32x2 __attribute__((ext_vector_type(2)));
typedef float f32x4 __attribute__((ext_vector_type(4)));
typedef float f32x16 __attribute__((ext_vector_type(16)));
typedef unsigned u32x2 __attribute__((ext_vector_type(2)));
typedef unsigned u32x4 __attribute__((ext_vector_type(4)));
typedef GAS unsigned gu32;

constexpr int NB = 4, SEQ = 2048, DM = 2048, NTOK = NB * SEQ, FF = 5632;
constexpr int NHEAD = 16, NKVH = 4, HDIM = 128, IHEAD = 16, IDIM = 64, TOPK = 256;
constexpr int DSA_IN = 4176, DSA_NPAD = 4352;
constexpr float RMS_EPS = 1e-6f;
constexpr int ADA_E = 9 * DM;

constexpr size_t MiB = 1u << 20;
constexpr size_t WS_CTL = 0, CTL_ZERO_BYTES = 1 * MiB;
constexpr size_t WS_ADA = 1 * MiB;
constexpr size_t WS_COSQ = 2 * MiB, WS_SINQ = WS_COSQ + 512 * 1024;
constexpr size_t WS_COSI = 3 * MiB, WS_SINI = WS_COSI + 256 * 1024;
constexpr size_t WS_WI = WS_COSI + 512 * 1024;
constexpr size_t WS_KI = 4 * MiB;
constexpr size_t WS_MASK = 5 * MiB;
constexpr size_t WS_WGU = 8 * MiB;
constexpr size_t WS_WD = WS_WGU + 4 * 44 * MiB;
constexpr size_t WS_PWIN = WS_WD + 4 * 22 * MiB;
constexpr size_t WS_PWGRP = WS_PWIN + 8 * MiB;
constexpr size_t WS_PWOUT = WS_PWGRP + 2 * MiB;
constexpr size_t WS_DWIN = WS_PWOUT + 8 * MiB;
constexpr size_t WS_DWOUT = WS_DWIN + 17 * MiB;
constexpr size_t WS_Y = WS_DWOUT + 8 * MiB + 5 * MiB;
constexpr size_t WS_BIG = WS_Y + 32 * MiB;
constexpr size_t WS_O = WS_BIG + 96 * MiB;
constexpr size_t WS_END = WS_O + 32 * MiB;
static_assert(WS_Y == 320 * MiB, "ws map");
constexpr size_t BIG_U = 0, BIG_P = 32 * MiB, BIG_V = 64 * MiB;
constexpr size_t BIG_Q = 0, BIG_K = 32 * MiB, BIG_VV = 40 * MiB, BIG_QI = 48 * MiB, BIG_KWP = 64 * MiB;

constexpr int CW_TMO = 0, CW_QUEUE = 64, CW_BAR = 4096;

constexpr int RING_BYTES = 131072;
constexpr int LDSCTL_OFF = RING_BYTES, MISC_OFF = LDSCTL_OFF + 320;
constexpr int LDS_BYTES = 147456;
constexpr int NWAVES = 8;

#define LDS_WAIT() asm volatile("s_waitcnt lgkmcnt(0)" ::: "memory")
#define VM_WAIT() asm volatile("s_waitcnt vmcnt(0)" ::: "memory")
#define RLX_AGENT __ATOMIC_RELAXED, __HIP_MEMORY_SCOPE_AGENT

__device__ __forceinline__ unsigned cvt_pk_bf16(float lo, float hi) { unsigned r; asm volatile("v_cvt_pk_bf16_f32 %0, %1, %2" : "=v"(r) : "v"(lo), "v"(hi)); return r; }
__device__ __forceinline__ float bf_lo(unsigned w) { return __uint_as_float(w << 16); }
__device__ __forceinline__ float bf_hi(unsigned w) { return __uint_as_float(w & 0xffff0000u); }
__device__ __forceinline__ float wave_sum(float v) {
#pragma unroll
    for (int o = 1; o < 64; o <<= 1) v += __shfl_xor(v, o);
    return v;
}

__device__ const float INVF_Q[16] = {1.0f, 0.44036659598350525f, 0.1939227432012558f, 0.08539710193872452f, 0.03760603070259094f, 0.01656043902039528f, 0.007292664609849453f, 0.0032114458736032248f,
                                     0.0014142135623842478f, 0.000622772378847003f, 0.00027424818836152554f, 0.00012076973507646471f, 5.318296098266728e-05f, 2.34199997066753e-05f, 1.0313386155758053e-05f, 4.541670477919979e-06f};
__device__ const float INVF_I[8] = {1.0f, 0.1939227432012558f, 0.03760603070259094f, 0.007292664609849453f, 0.0014142135623842478f, 0.00027424818836152554f, 5.318296098266728e-05f, 1.0313386155758053e-05f};

__device__ __forceinline__ void sincos_acc(float xf, float& sn, float& cs) {
    const double x = (double)xf;
    const double q = rint(x * 0.63661977236758134308);
    const double r = fma(-q, 1.57079632679489661923, x) - q * 6.123233995736766e-17;
    const double r2 = r * r;
    double sp = -2.5052108385441720e-08; sp = sp * r2 + 2.7557319223985893e-06; sp = sp * r2 - 1.9841269841269841e-04; sp = sp * r2 + 8.3333333333333332e-03; sp = sp * r2 - 1.6666666666666666e-01;
    const double s = r + r * r2 * sp;
    double cp = 2.0876756987868099e-09; cp = cp * r2 - 2.7557319223985888e-07; cp = cp * r2 + 2.4801587301587302e-05; cp = cp * r2 - 1.3888888888888889e-03; cp = cp * r2 + 4.1666666666666664e-02; cp = cp * r2 - 0.5;
    const double c = 1.0 + r2 * cp;
    const int qi = ((int)q) & 3;
    const double ss = (qi == 0) ? s : (qi == 1) ? c : (qi == 2) ? -s : -c;
    const double cc = (qi == 0) ? c : (qi == 1) ? -s : (qi == 2) ? -c : s;
    sn = (float)ss; cs = (float)cc;
}

namespace pg8 {
#define PG8_LAS __attribute__((address_space(3)))
constexpr int BM = 256, BK = 64, HALF = 128, HTB = HALF * BK * 2, STAGE_BYTES = 8 * HTB, NXCD = 8, WGM = 8;
__host__ __device__ __forceinline__ int lds_byte(int r, int c) { const int st = (r >> 4) * 2 + (c >> 5), rr = r & 15, cc = c & 31, ob = rr * 64 + cc * 2; return st * 1024 + (ob ^ (((ob >> 9) & 1) << 5)); }
__host__ __device__ __forceinline__ void stage_rc(int b, int& R, int& C) { const int st = b / 1024, sb = b % 1024, swz = sb ^ (((sb >> 9) & 1) << 5); R = (st >> 1) * 16 + swz / 64; C = (st & 1) * 32 + (swz % 64) / 2; }
__host__ __device__ __forceinline__ int perm32(int rho) { const int n = rho >> 4, i = rho & 15; return 8 * (i >> 2) + 4 * n + (i & 3); }

struct Unit { int pm, pn; long aoff, boff; };
struct Gemm { const bf16_t* A; const bf16_t* Bt; int lda, ldb, K; };

struct StaticOrder {
    int nM, nN, nwg, G, c, a_sh; long a_m, a_n, b_n;
    __device__ void init(int nM_, int nN_, int G_, int c_, long a_m_, int a_sh_, long a_n_, long b_n_) { nM = nM_; nN = nN_; nwg = nM * nN; G = G_; c = c_; a_m = a_m_; a_sh = a_sh_; a_n = a_n_; b_n = b_n_; }
    __device__ bool next(int i, Unit& u) const {
        const long L = (long)i * G + c; if (L >= nwg) return false;
        int wgid = (int)L; { const int q = nwg / NXCD, r = nwg % NXCD, xcd = wgid % NXCD, off = wgid / NXCD; wgid = (xcd < r ? xcd * (q + 1) : r * (q + 1) + (xcd - r) * q) + off; }
        const int nig = WGM * nN, gid = wgid / nig, fm = gid * WGM, gsz = (nM - fm) < WGM ? (nM - fm) : WGM;
        u.pm = fm + ((wgid % nig) % gsz); u.pn = (wgid % nig) / gsz;
        u.aoff = (long)u.pm * a_m + (long)(u.pn >> a_sh) * a_n; u.boff = (long)u.pn * b_n; return true;
    }
    __device__ __forceinline__ void a_ready(const Unit&) const {}
    __device__ __forceinline__ void done(const Unit&) const {}
};

__device__ __forceinline__ u32x4 pack8(const f32x4& v0, const f32x4& v1) { u32x4 w; w.x = cvt_pk_bf16(v0[0], v0[1]); w.y = cvt_pk_bf16(v0[2], v0[3]); w.z = cvt_pk_bf16(v1[0], v1[1]); w.w = cvt_pk_bf16(v1[2], v1[3]); return w; }

struct EpiBf16 {
    static constexpr bool PERM = true, AFTER_DRAIN = false;
    bf16_t* O; int ldc;
    __device__ __forceinline__ void operator()(const f32x4 (&acc)[2][2][4][2], const Unit& u, int wr, int wc, int fr, int fq) const {
        const int row0 = u.pm * BM + wr * 64 + fr, col0 = u.pn * BM + wc * 32 + 8 * fq;
#pragma unroll
        for (int ai = 0; ai < 2; ++ai)
#pragma unroll
            for (int m = 0; m < 4; ++m) { bf16_t* rowp = O + (size_t)(row0 + ai * HALF + m * 16) * ldc + col0;
#pragma unroll
                for (int bj = 0; bj < 2; ++bj) *(u32x4*)(rowp + bj * HALF) = pack8(acc[ai][bj][m][0], acc[ai][bj][m][1]); }
    }
};
struct EpiSwiglu {
    static constexpr bool PERM = true, AFTER_DRAIN = false;
    bf16_t* O; int ldc;
    __device__ __forceinline__ void operator()(const f32x4 (&acc)[2][2][4][2], const Unit& u, int wr, int wc, int fr, int fq) const {
        const int row0 = u.pm * BM + wr * 64 + fr, col0 = u.pn * HALF + wc * 32 + 8 * fq;
#pragma unroll
        for (int ai = 0; ai < 2; ++ai)
#pragma unroll
            for (int m = 0; m < 4; ++m) {
                f32x4 o[2];
#pragma unroll
                for (int n = 0; n < 2; ++n)
#pragma unroll
                    for (int e = 0; e < 4; ++e) { const float g = acc[ai][0][m][n][e], uu = acc[ai][1][m][n][e];
                        o[n][e] = g * uu * __builtin_amdgcn_rcpf(1.0f + __builtin_amdgcn_exp2f(-1.4426950408889634f * g)); }
                *(u32x4*)(O + (size_t)(row0 + ai * HALF + m * 16) * ldc + col0) = pack8(o[0], o[1]); }
    }
};
struct EpiResid {
    static constexpr bool PERM = false, AFTER_DRAIN = false;
    float* H; const float* gate0; float coef;
    __device__ __forceinline__ void operator()(const f32x4 (&acc)[2][2][4][2], const Unit& u, int wr, int wc, int fr, int fq) const {
        const int row0 = u.pm * BM + wr * 64 + fr, col0 = u.pn * BM + wc * 32 + 4 * fq;
        const float* gp = gate0 + (size_t)(u.pm >> 3) * (2 * ADA_E) + col0;
        f32x4 gv[2][2];
#pragma unroll
        for (int bj = 0; bj < 2; ++bj)
#pragma unroll
            for (int n = 0; n < 2; ++n) gv[bj][n] = *(const f32x4*)(gp + bj * HALF + n * 16) * coef;
#pragma unroll
        for (int ai = 0; ai < 2; ++ai)
#pragma unroll
            for (int m = 0; m < 4; ++m) { float* rowp = H + (size_t)(row0 + ai * HALF + m * 16) * DM + col0;
#pragma unroll
                for (int bj = 0; bj < 2; ++bj)
#pragma unroll
                    for (int n = 0; n < 2; ++n) { f32x4* p = (f32x4*)(rowp + bj * HALF + n * 16); *p = *p + gv[bj][n] * acc[ai][bj][m][n]; }
                if (m & 1) asm volatile("" ::: "memory"); }
    }
};
struct EpiDsaIn {
    static constexpr bool PERM = true, AFTER_DRAIN = false;
    bf16_t *Q, *K, *V, *QI; const float *cosq, *sinq, *cosi, *sini;
    __device__ __forceinline__ void operator()(const f32x4 (&acc)[2][2][4][2], const Unit& u, int wr, int wc, int fr, int fq) const {
        const int row0 = u.pm * BM + wr * 64 + fr, pn = u.pn;
        bf16_t* base; int ldc, colt; int mode;
        if (pn < 8) { base = Q; ldc = DM; colt = pn * BM; mode = (wc == 0) ? 1 : 0; }
        else if (pn < 10) { base = K; ldc = 512; colt = (pn - 8) * BM; mode = (wc == 0) ? 1 : 0; }
        else if (pn < 12) { base = V; ldc = 512; colt = (pn - 10) * BM; mode = 0; }
        else { base = QI; ldc = 1024; colt = (pn - 12) * BM; mode = ((wc & 1) == 0 && fq < 2) ? 2 : 0; }
        const int col0 = colt + wc * 32 + 8 * fq;
#pragma unroll
        for (int ai = 0; ai < 2; ++ai)
#pragma unroll
            for (int m = 0; m < 4; ++m) { const int row = row0 + ai * HALF + m * 16;
                f32x4 cs = {1.f, 1.f, 1.f, 1.f}, sn = {0.f, 0.f, 0.f, 0.f};
                if (mode == 1) { cs = *(const f32x4*)(cosq + (size_t)row * 16 + 4 * fq); sn = *(const f32x4*)(sinq + (size_t)row * 16 + 4 * fq); }
                else if (mode == 2) { cs = *(const f32x4*)(cosi + (size_t)row * 8 + 4 * fq); sn = *(const f32x4*)(sini + (size_t)row * 8 + 4 * fq); }
#pragma unroll
                for (int bj = 0; bj < 2; ++bj) { const f32x4 a = acc[ai][bj][m][0], b = acc[ai][bj][m][1]; f32x4 oa, ob;
                    oa[0] = a[0] * cs[0] - a[1] * sn[0]; oa[1] = a[1] * cs[0] + a[0] * sn[0]; oa[2] = a[2] * cs[1] - a[3] * sn[1]; oa[3] = a[3] * cs[1] + a[2] * sn[1];
                    ob[0] = b[0] * cs[2] - b[1] * sn[2]; ob[1] = b[1] * cs[2] + b[0] * sn[2]; ob[2] = b[2] * cs[3] - b[3] * sn[3]; ob[3] = b[3] * cs[3] + b[2] * sn[3];
                    *(u32x4*)(base + (size_t)row * ldc + col0 + bj * HALF) = pack8(oa, ob); } }
    }
};
struct EpiKW {
    static constexpr bool PERM = false, AFTER_DRAIN = false;
    float* P;
    __device__ __forceinline__ void operator()(const f32x4 (&acc)[2][2][4][2], const Unit& u, int wr, int wc, int fr, int fq) const {
        const int row0 = u.pm * BM + wr * 64 + fr, col0 = wc * 32 + 4 * fq;
        float* pb = P + (size_t)u.pn * NTOK * 128;
#pragma unroll
        for (int ai = 0; ai < 2; ++ai)
#pragma unroll
            for (int m = 0; m < 4; ++m) { float* rowp = pb + (size_t)(row0 + ai * HALF + m * 16) * 128 + col0;
#pragma unroll
                for (int n = 0; n < 2; ++n) *(f32x4*)(rowp + n * 16) = acc[ai][0][m][n]; }
    }
};

template <class Epi, class Sched, bool ALIGN_EPI = false, bool SP2 = false>
__device__ __forceinline__ void gemm_phase(PG8_LAS unsigned char* lds, const Gemm g, const Sched& S, const Epi& E) {
    int tid_ = threadIdx.x; asm volatile("" : "+v"(tid_));
    const int tid = tid_, wid = __builtin_amdgcn_readfirstlane(tid >> 6), lane = tid & 63, wr = wid >> 2, wc = wid & 3, fr = lane & 15, fq = lane >> 4;
    const int K = g.K, nt = K / BK;
    unsigned voffA[2], voffB[2];
#pragma unroll
    for (int i = 0; i < 2; ++i) { int R, C; stage_rc(tid * 16 + i * 8192, R, C); const int Rb = Epi::PERM ? ((R & ~31) + perm32(R & 31)) : R;
        voffA[i] = (unsigned)(R * g.lda + C) * 2u; voffB[i] = (unsigned)(Rb * g.ldb + C) * 2u; }
    const size_t kstep = (size_t)(BK * 2);
    const size_t hstepA = (size_t)HALF * g.lda * 2, hstepB = (size_t)HALF * g.ldb * 2;
    const unsigned ldsw = (unsigned)wid * 1024u;
    const int aoff = lds_byte(wr * 64 + fr, fq * 8), boff = lds_byte(wc * 32 + fr, fq * 8);
#define PG8_SA(b, h) (((b) * 2 + (h)) * HTB)
#define PG8_SB(b, h) ((4 + (b) * 2 + (h)) * HTB)
#define PG8_STAGE(bufoff, gbase, voff) do { _Pragma("unroll") for (int _i = 0; _i < 2; ++_i) \
        __builtin_amdgcn_global_load_lds((const unsigned*)((const char*)(gbase) + (voff)[_i]), (PG8_LAS unsigned*)(lds + (bufoff) + ldsw + _i * 8192), 16, 0, 0); } while (0)
#define PG8_LDA(dst, b, h) do { _Pragma("unroll") for (int m = 0; m < 4; ++m) _Pragma("unroll") for (int k = 0; k < 2; ++k) dst[m][k] = *(const PG8_LAS bf16x8*)(lds + PG8_SA(b, h) + aoff + m * 2048 + k * 1024); } while (0)
#define PG8_LDB(dst, b, h) do { _Pragma("unroll") for (int n = 0; n < 2; ++n) _Pragma("unroll") for (int k = 0; k < 2; ++k) dst[n][k] = *(const PG8_LAS bf16x8*)(lds + PG8_SB(b, h) + boff + n * 2048 + k * 1024); } while (0)
#define PG8_MMA(ai, bj, At, Bt) do { __builtin_amdgcn_s_setprio(1); _Pragma("unroll") for (int m = 0; m < 4; ++m) _Pragma("unroll") for (int n = 0; n < 2; ++n) _Pragma("unroll") for (int k = 0; k < 2; ++k) \
        acc[ai][bj][m][n] = __builtin_amdgcn_mfma_f32_16x16x32_bf16(Bt[n][k], At[m][k], acc[ai][bj][m][n], 0, 0, 0); __builtin_amdgcn_s_setprio(0); } while (0)
#define PG8_WAIT_V(n) asm volatile("s_waitcnt vmcnt(" #n ")" ::: "memory")
#define PG8_WAIT_L(n) asm volatile("s_waitcnt lgkmcnt(" #n ")" ::: "memory")
#define PG8_BAR __builtin_amdgcn_s_barrier()
#define PG8_SCHED __builtin_amdgcn_sched_barrier(0)
    Unit cur, nxt; int ui = 0;
    if (!S.next(0, cur)) return;
    f32x4 acc[2][2][4][2];
#pragma unroll
    for (int a = 0; a < 2; ++a)
#pragma unroll
        for (int b = 0; b < 2; ++b)
#pragma unroll
            for (int m = 0; m < 4; ++m)
#pragma unroll
                for (int n = 0; n < 2; ++n) acc[a][b][m][n] = (f32x4){0.f, 0.f, 0.f, 0.f};
    bf16x8 At[4][2], B0[2][2], B1[2][2];
    const char* cA = (const char*)g.A + cur.aoff; const char* cB = (const char*)g.Bt + cur.boff;
    S.a_ready(cur);
    if constexpr (SP2) {
        PG8_STAGE(PG8_SB(0, 0), cB, voffB); PG8_STAGE(PG8_SB(0, 1), cB + hstepB, voffB); PG8_STAGE(PG8_SA(0, 0), cA, voffA); PG8_STAGE(PG8_SA(0, 1), cA + hstepA, voffA);
        if (wr == 1) PG8_BAR;
        PG8_WAIT_V(2); PG8_BAR;
        PG8_STAGE(PG8_SB(1, 0), cB + kstep, voffB); PG8_STAGE(PG8_SA(1, 0), cA + kstep, voffA); PG8_STAGE(PG8_SB(1, 1), cB + hstepB + kstep, voffB);
        PG8_WAIT_V(6); PG8_BAR;
    } else {
        PG8_STAGE(PG8_SB(0, 0), cB, voffB); PG8_STAGE(PG8_SA(0, 0), cA, voffA); PG8_STAGE(PG8_SB(0, 1), cB + hstepB, voffB); PG8_STAGE(PG8_SA(0, 1), cA + hstepA, voffA);
        if (wr == 1) PG8_BAR;
        PG8_WAIT_V(4); PG8_BAR;
        PG8_STAGE(PG8_SB(1, 0), cB + kstep, voffB); PG8_STAGE(PG8_SA(1, 0), cA + kstep, voffA); PG8_STAGE(PG8_SB(1, 1), cB + hstepB + kstep, voffB);
        PG8_WAIT_V(6); PG8_BAR;
    }
    for (;;) {
        const bool has_next = S.next(ui + 1, nxt);
        const char* nA = has_next ? (const char*)g.A + nxt.aoff : cA; const char* nB = has_next ? (const char*)g.Bt + nxt.boff : cB;
        for (int t = 0; t < nt; t += 2) {
            const bool last = (t == nt - 2);
            const char* a1 = cA + (size_t)(t + 1) * kstep;
            const char* a2 = last ? nA : cA + (size_t)(t + 2) * kstep; const char* b2 = last ? nB : cB + (size_t)(t + 2) * kstep;
            const char* a3 = a2 + kstep; const char* b3 = b2 + kstep;
            if (last && has_next) S.a_ready(nxt);
            if constexpr (SP2) {
            PG8_LDB(B0, 0, 0); PG8_LDB(B1, 0, 1); PG8_SCHED; PG8_LDA(At, 0, 0); PG8_STAGE(PG8_SA(1, 1), a1 + hstepA, voffA);
            PG8_WAIT_V(8); PG8_WAIT_L(0); PG8_BAR; PG8_MMA(0, 0, At, B0); PG8_MMA(0, 1, At, B1); PG8_BAR; PG8_SCHED;
            PG8_LDA(At, 0, 1); PG8_STAGE(PG8_SB(0, 0), b2, voffB); PG8_STAGE(PG8_SB(0, 1), b2 + hstepB, voffB); PG8_STAGE(PG8_SA(0, 0), a2, voffA);
            PG8_WAIT_V(8); PG8_WAIT_L(0); PG8_BAR; PG8_MMA(1, 0, At, B0); PG8_MMA(1, 1, At, B1); PG8_BAR; PG8_SCHED;
            PG8_LDB(B0, 1, 0); PG8_LDB(B1, 1, 1); PG8_SCHED; PG8_LDA(At, 1, 0); PG8_STAGE(PG8_SA(0, 1), a2 + hstepA, voffA);
            PG8_WAIT_V(8); PG8_WAIT_L(0); PG8_BAR; PG8_MMA(0, 0, At, B0); PG8_MMA(0, 1, At, B1); PG8_BAR; PG8_SCHED;
            PG8_LDA(At, 1, 1); PG8_STAGE(PG8_SB(1, 0), b3, voffB); PG8_STAGE(PG8_SB(1, 1), b3 + hstepB, voffB); PG8_STAGE(PG8_SA(1, 0), a3, voffA);
            PG8_WAIT_V(8); PG8_WAIT_L(0); PG8_BAR; PG8_MMA(1, 0, At, B0); PG8_MMA(1, 1, At, B1); PG8_BAR; PG8_SCHED;
            } else {
            PG8_LDB(B0, 0, 0); PG8_SCHED; PG8_LDA(At, 0, 0); PG8_STAGE(PG8_SA(1, 1), a1 + hstepA, voffA);
            PG8_WAIT_L(8); PG8_BAR; PG8_WAIT_L(0); PG8_MMA(0, 0, At, B0); PG8_BAR; PG8_SCHED;
            PG8_LDB(B1, 0, 1); PG8_STAGE(PG8_SB(0, 0), b2, voffB);
            PG8_BAR; PG8_WAIT_L(0); PG8_MMA(0, 1, At, B1); PG8_BAR;
            PG8_LDA(At, 0, 1); PG8_STAGE(PG8_SA(0, 0), a2, voffA);
            PG8_BAR; PG8_WAIT_L(0); PG8_MMA(1, 0, At, B0); PG8_BAR; PG8_SCHED;
            PG8_STAGE(PG8_SB(0, 1), b2 + hstepB, voffB);
            PG8_WAIT_V(6); PG8_BAR; PG8_MMA(1, 1, At, B1); PG8_BAR;
            PG8_LDB(B0, 1, 0); PG8_SCHED; PG8_LDA(At, 1, 0); PG8_STAGE(PG8_SA(0, 1), a2 + hstepA, voffA);
            PG8_WAIT_L(8); PG8_BAR; PG8_WAIT_L(0); PG8_MMA(0, 0, At, B0); PG8_BAR; PG8_SCHED;
            PG8_LDB(B1, 1, 1); PG8_STAGE(PG8_SB(1, 0), b3, voffB);
            PG8_BAR; PG8_WAIT_L(0); PG8_MMA(0, 1, At, B1); PG8_BAR;
            PG8_LDA(At, 1, 1); PG8_STAGE(PG8_SA(1, 0), a3, voffA);
            PG8_BAR; PG8_WAIT_L(0); PG8_MMA(1, 0, At, B0); PG8_BAR; PG8_SCHED;
            PG8_STAGE(PG8_SB(1, 1), b3 + hstepB, voffB);
            PG8_WAIT_V(6); PG8_BAR; PG8_MMA(1, 1, At, B1); PG8_BAR;
            }
        }
        if constexpr (ALIGN_EPI) { if (wr == 0) PG8_BAR; }
        if constexpr (!Epi::AFTER_DRAIN) { E(acc, cur, wr, wc, fr, fq); S.done(cur); }
        if (!has_next) break;
#pragma unroll
        for (int a = 0; a < 2; ++a)
#pragma unroll
            for (int b = 0; b < 2; ++b)
#pragma unroll
                for (int m = 0; m < 4; ++m)
#pragma unroll
                    for (int n = 0; n < 2; ++n) acc[a][b][m][n] = (f32x4){0.f, 0.f, 0.f, 0.f};
        cur = nxt; cA = nA; cB = nB; ++ui;
        if constexpr (ALIGN_EPI) { if (wr == 1) PG8_BAR; }
    }
    PG8_WAIT_V(0);
    if constexpr (!ALIGN_EPI) { if (wr == 0) PG8_BAR; }
    PG8_BAR;
    if constexpr (Epi::AFTER_DRAIN) { E.fused(acc, cur, wr, wc, fr, fq, lds, wid, lane); S.done(cur); }
#undef PG8_SA
#undef PG8_SB
#undef PG8_STAGE
#undef PG8_LDA
#undef PG8_LDB
#undef PG8_MMA
#undef PG8_WAIT_V
#undef PG8_WAIT_L
#undef PG8_BAR
#undef PG8_SCHED
}
}

namespace attn {
constexpr int D = 128, QS = 2048, KS = 512, OS = 2048;
constexpr float SCALE = 0.08838834764831845f;
constexpr float THR = 8.f;
constexpr int NW = 8, QBLK = 32, KVBLK = 64, QB = NW * QBLK;
constexpr int SHM_V = KVBLK * D * 2, SHM_K = KVBLK * D * 2;
constexpr int ATT_LDS = 2 * SHM_V + 2 * SHM_K + NW * 64 * 4;
typedef const CAS unsigned long long* cu64p;

#define KSWZ(row, colB) ((row) * 256 + ((colB) ^ (((row) & 7) << 4)))
#define SBAR() __builtin_amdgcn_sched_barrier(0)
__device__ __forceinline__ int v_st(int k, int c) { const int kk = (k & ~0xC) | ((k & 4) << 1) | ((k & 8) >> 1); return ((kk >> 3) * 4 + (c >> 5)) * 512 + ((kk & 7) * 32 + (c & 31)) * 2; }
__device__ __forceinline__ int v_rd_base(int lane) { return ((lane & 3) << 3) | (((lane >> 2) & 3) << 6) | (((lane >> 4) & 1) << 5) | (((lane >> 5) & 1) << 8); }
constexpr int v_rd_off(int d0, int ks, int half) { return d0 * 512 + ks * 4096 + half * 2048; }
__device__ __forceinline__ int crow(int r, int hi) { return (r & 3) + 8 * (r >> 2) + 4 * hi; }
__device__ __forceinline__ unsigned cvtpk(float lo, float hi) { unsigned r; asm volatile("v_cvt_pk_bf16_f32 %0, %1, %2" : "=v"(r) : "v"(lo), "v"(hi)); return r; }
__device__ __forceinline__ bf16x8 load8(const bf16_t* p) { return *reinterpret_cast<const bf16x8*>(p); }

__device__ __forceinline__ void mask_sel(f32x16& p0, f32x16& p1, cu64p mw) {
    const float NEG = -__builtin_inff();
#pragma unroll
    for (int r = 0; r < 16; ++r) { const unsigned long long w0 = mw[r]; p0[r] = __builtin_amdgcn_inverse_ballot_w64(w0) ? p0[r] : NEG; }
    __builtin_amdgcn_sched_barrier(0);
#pragma unroll
    for (int r = 0; r < 16; ++r) { const unsigned long long w1 = mw[16 + r]; p1[r] = __builtin_amdgcn_inverse_ballot_w64(w1) ? p1[r] : NEG; }
}
__device__ __forceinline__ void partialSM(f32x16& p0, f32x16& p1, float& m_reg, float& mn, float& alpha) {
    float pmax = p0[0];
#pragma unroll
    for (int r = 1; r < 16; ++r) pmax = fmaxf(pmax, p0[r]);
#pragma unroll
    for (int r = 0; r < 16; ++r) pmax = fmaxf(pmax, p1[r]);
    { auto rr = __builtin_amdgcn_permlane32_swap(__float_as_uint(pmax), __float_as_uint(pmax), false, false);
      pmax = fmaxf(__uint_as_float(rr[0]), __uint_as_float(rr[1])); }
    constexpr float C2 = 1.4426950408889634f * SCALE;
    if (__builtin_expect(__all((pmax - m_reg) * SCALE <= THR), 1)) { mn = m_reg; alpha = 1.f; }
    else { mn = fmaxf(m_reg, pmax); alpha = __builtin_amdgcn_exp2f((m_reg - mn) * C2); m_reg = mn; }
    const float mnL = -mn * C2;
#pragma unroll
    for (int r = 0; r < 16; ++r) p0[r] = fmaf(p0[r], C2, mnL);
#pragma unroll
    for (int r = 0; r < 16; ++r) p1[r] = fmaf(p1[r], C2, mnL);
#pragma unroll
    for (int r = 0; r < 16; ++r) p0[r] = __builtin_amdgcn_exp2f(p0[r]);
}
__device__ __forceinline__ void finishSM(f32x16& p0, f32x16& p1, float alpha, float& l_reg, bf16x8& pa0, bf16x8& pa1, bf16x8& pa2, bf16x8& pa3) {
#pragma unroll
    for (int r = 0; r < 16; ++r) p1[r] = __builtin_amdgcn_exp2f(p1[r]);
    float ps = 0;
#pragma unroll
    for (int r = 0; r < 16; ++r) ps += p0[r];
#pragma unroll
    for (int r = 0; r < 16; ++r) ps += p1[r];
    { auto rr = __builtin_amdgcn_permlane32_swap(__float_as_uint(ps), __float_as_uint(ps), false, false);
      ps = __uint_as_float(rr[0]) + __uint_as_float(rr[1]); }
    l_reg = l_reg * alpha + ps;
#define PK4(P, B_, OUT) do { unsigned a0 = cvtpk(P[B_+0], P[B_+1]), a1 = cvtpk(P[B_+2], P[B_+3]);                          \
        unsigned b0 = cvtpk(P[B_+4], P[B_+5]), b1 = cvtpk(P[B_+6], P[B_+7]);                                             \
        auto r0 = __builtin_amdgcn_permlane32_swap(a0, b0, false, false); auto r1 = __builtin_amdgcn_permlane32_swap(a1, b1, false, false); \
        u32x4 w = {r0[0], r1[0], r0[1], r1[1]}; OUT = *reinterpret_cast<bf16x8*>(&w); } while (0)
    PK4(p0, 0, pa0); PK4(p0, 8, pa1); PK4(p1, 0, pa2); PK4(p1, 8, pa3);
#undef PK4
}
template <int KB>
__device__ __forceinline__ void qkt(f32x16& p0, f32x16& p1, const char* K_lds, int r32, int hi, const bf16x8* qr) {
    p0 = f32x16{}; p1 = f32x16{};
    const char* kb[4];
#pragma unroll
    for (int dd = 0; dd < 4; ++dd) kb[dd] = K_lds + KB * SHM_K + KSWZ(r32, (dd * 16 + hi * 8) * 2);
#pragma unroll
    for (int d0 = 0; d0 < 8; ++d0) { const char* a = kb[d0 & 3] + (d0 >> 2) * 128;
        bf16x8 b0 = *reinterpret_cast<const bf16x8*>(a);
        bf16x8 b1 = *reinterpret_cast<const bf16x8*>(a + 32 * 256);
        p0 = __builtin_amdgcn_mfma_f32_32x32x16_bf16(b0, qr[d0], p0, 0, 0, 0);
        p1 = __builtin_amdgcn_mfma_f32_32x32x16_bf16(b1, qr[d0], p1, 0, 0, 0); }
}
template <int VB>
__device__ __forceinline__ void pv_tile(f32x16* o, int vb0, bf16x8 pa0, bf16x8 pa1, bf16x8 pa2, bf16x8 pa3) {
#define TRRD(dst, off) asm volatile("ds_read_b64_tr_b16 %0, %1 offset:%2" : "=&v"(dst) : "v"(vb0), "i"(off) : "memory")
#define PV_D0(d0) do { s16x4 l0, l1, l2, l3, h0, h1, h2, h3; constexpr int b_ = VB * SHM_V + v_rd_off(d0, 0, 0); \
        TRRD(l0, b_); TRRD(h0, b_ + 2048); TRRD(l1, b_ + 4096); TRRD(h1, b_ + 6144); TRRD(l2, b_ + 8192); TRRD(h2, b_ + 10240); TRRD(l3, b_ + 12288); TRRD(h3, b_ + 14336); \
        asm volatile("s_waitcnt lgkmcnt(0)" ::: "memory"); SBAR();   \
        o[d0] = __builtin_amdgcn_mfma_f32_32x32x16_bf16(pa0, (bf16x8){l0[0], l0[1], l0[2], l0[3], h0[0], h0[1], h0[2], h0[3]}, o[d0], 0, 0, 0);   \
        o[d0] = __builtin_amdgcn_mfma_f32_32x32x16_bf16(pa1, (bf16x8){l1[0], l1[1], l1[2], l1[3], h1[0], h1[1], h1[2], h1[3]}, o[d0], 0, 0, 0);   \
        o[d0] = __builtin_amdgcn_mfma_f32_32x32x16_bf16(pa2, (bf16x8){l2[0], l2[1], l2[2], l2[3], h2[0], h2[1], h2[2], h2[3]}, o[d0], 0, 0, 0);   \
        o[d0] = __builtin_amdgcn_mfma_f32_32x32x16_bf16(pa3, (bf16x8){l3[0], l3[1], l3[2], l3[3], h3[0], h3[1], h3[2], h3[3]}, o[d0], 0, 0, 0); } while (0)
    PV_D0(0); PV_D0(1); PV_D0(2); PV_D0(3);
#undef PV_D0
#undef TRRD
}

struct BlockRef { const bf16_t* Q; const bf16_t* K; const bf16_t* V; bf16_t* O; cu64p M; int P0; };
struct Seam { bf16x8 qr[8]; bf16x8 st_v0, st_v1, st_k0, st_k1; };
#define ROW(p, k0, rr) ((p) + (size_t)((k0) + (rr)) * KS + sc)
#define VMW() asm volatile("s_waitcnt vmcnt(0)" ::: "memory")
#define VMWN(n) asm volatile("s_waitcnt vmcnt(%0)" :: "i"(n) : "memory")
#define SLOAD_H(Kp, Vp, k0) do { S.st_v0 = load8(ROW(Vp, k0, sr)); S.st_v1 = load8(ROW(Vp, k0, 32 + sr));              \
                         S.st_k0 = load8(ROW(Kp, k0, sr)); S.st_k1 = load8(ROW(Kp, k0, 32 + sr)); } while (0)
#define SWRITE_HK(bf) do { *(bf16x8*)(K_lds + (bf) * SHM_K + kws) = S.st_k0; *(bf16x8*)(K_lds + (bf) * SHM_K + kws + 32 * 256) = S.st_k1; } while (0)
#define SWRITE_HV(bf) do { *(bf16x8*)(V_lds + (bf) * SHM_V + vst0) = S.st_v0; *(bf16x8*)(V_lds + (bf) * SHM_V + vst1) = S.st_v1; } while (0)
#define SWRITE_H(bf) do { SWRITE_HV(bf); SWRITE_HK(bf); } while (0)
__device__ __forceinline__ void attn_prime(const BlockRef& cur, char* lds, Seam& S) {
    int tid_ = threadIdx.x; asm volatile("" : "+v"(tid_));
    const int tid = tid_, wid = __builtin_amdgcn_readfirstlane(tid >> 6), lane = tid & 63, r32 = lane & 31, hi = lane >> 5;
    const int sr = tid >> 4, sc = (tid & 15) * 8, kws = KSWZ(sr, sc * 2); char* K_lds = lds + 2 * SHM_V;
#pragma unroll
    for (int d0 = 0; d0 < 8; ++d0) S.qr[d0] = load8(cur.Q + (size_t)(wid * QBLK + r32) * QS + d0 * 16 + hi * 8);
    SLOAD_H(cur.K, cur.V, 0); VMW(); SWRITE_HK(0);
    __syncthreads();
}
__device__ __forceinline__ void attn_block(const BlockRef& cur, const BlockRef& nxt, char* lds, Seam& S) {
    int tid_ = threadIdx.x; asm volatile("" : "+v"(tid_));
    const int tid = tid_, wid = __builtin_amdgcn_readfirstlane(tid >> 6), lane = tid & 63, r32 = lane & 31, hi = lane >> 5;
    const int NT = (cur.P0 + QB) / KVBLK;
    char* V_lds = lds; char* K_lds = lds + 2 * SHM_V;
    float* ws = (float*)(lds + 2 * SHM_V + 2 * SHM_K) + wid * 64; float* li_l = ws, * al_l = ws + 32;
    float m_reg = -1e30f, l_reg = 0; f32x16 o[4] = {};
    const int sr = tid >> 4, sc = (tid & 15) * 8, vst0 = v_st(sr, sc), vst1 = v_st(32 + sr, sc), kws = KSWZ(sr, sc * 2);
    const int vb0 = (int)(uintptr_t)V_lds + v_rd_base(lane);
    const bf16_t* Kh = cur.K; const bf16_t* Vh = cur.V;
    const cu64p mrow = cur.M + (size_t)wid * (32 * 32);
#define RESC(a) do { if (__any((a) < 1.f)) { if (hi == 0) al_l[r32] = (a); asm volatile("s_waitcnt lgkmcnt(0)" ::: "memory");              \
                     for (int d_ = 0; d_ < 4; ++d_) for (int r = 0; r < 16; ++r) o[d_][r] *= al_l[crow(r, hi)]; } } while (0)
#define KBASE(t) ((t) * KVBLK)
#define MASKT(P0_, P1_, t) mask_sel(P0_, P1_, mrow + (size_t)(t) * 32)
    constexpr int NQL = 8;
#define SEAM_K0() do { VMWN(NQL); SWRITE_HK(0); SBAR(); } while (0)
    f32x16 pA0, pA1, pB0, pB1; float mnA, mnB, alA, alB; bf16x8 pa0, pa1, pa2, pa3;
    SWRITE_HV(0); SBAR();
    if (NT > 1) { SLOAD_H(Kh, Vh, KBASE(1)); }
    SBAR(); qkt<0>(pA0, pA1, K_lds, r32, hi, S.qr);
    MASKT(pA0, pA1, 0); partialSM(pA0, pA1, m_reg, mnA, alA);
    if (NT > 1) { VMW(); SWRITE_H(1); }
    __syncthreads();
#define HALF_STEP(PX0, PX1, mnX, alX, PY0, PY1, alY, t, KB, VB, SB) do {                                                      \
        SBAR(); qkt<KB>(PX0, PX1, K_lds, r32, hi, S.qr);                                                         \
        finishSM(PY0, PY1, alY, l_reg, pa0, pa1, pa2, pa3); SBAR();                                                           \
        if ((t) + 1 < NT) { SLOAD_H(Kh, Vh, KBASE((t) + 1)); SBAR(); }                                               \
        pv_tile<VB>(o, vb0, pa0, pa1, pa2, pa3); MASKT(PX0, PX1, (t)); partialSM(PX0, PX1, m_reg, mnX, alX);                                        \
        __syncthreads();                                                                                                      \
        if ((t) + 1 < NT) { VMW(); SWRITE_H(SB); }                                                                          \
        RESC(alX); __syncthreads(); } while (0)
    for (int t = 1; t + 1 < NT; t += 2) {
        HALF_STEP(pB0, pB1, mnB, alB, pA0, pA1, alA, t, 1, 0, 0);
        HALF_STEP(pA0, pA1, mnA, alA, pB0, pB1, alB, t + 1, 0, 1, 1);
    }
    SBAR(); qkt<1>(pB0, pB1, K_lds, r32, hi, S.qr); SBAR();
    SLOAD_H(nxt.K, nxt.V, 0); SBAR();
#pragma unroll
    for (int d0 = 0; d0 < 8; ++d0) S.qr[d0] = load8(nxt.Q + (size_t)(wid * QBLK + r32) * QS + d0 * 16 + hi * 8);
    SBAR();
    finishSM(pA0, pA1, alA, l_reg, pa0, pa1, pa2, pa3); SBAR();
    pv_tile<0>(o, vb0, pa0, pa1, pa2, pa3);
    MASKT(pB0, pB1, NT - 1); partialSM(pB0, pB1, m_reg, mnB, alB); __syncthreads(); RESC(alB);
    finishSM(pB0, pB1, alB, l_reg, pa0, pa1, pa2, pa3); SBAR(); pv_tile<1>(o, vb0, pa0, pa1, pa2, pa3);
    SBAR(); SEAM_K0();
    if (hi == 0) li_l[r32] = l_reg; asm volatile("s_waitcnt lgkmcnt(0)" ::: "memory");
    float rli[16];
#pragma unroll
    for (int r = 0; r < 16; ++r) rli[r] = __builtin_amdgcn_rcpf(li_l[crow(r, hi)]);
    bf16_t* Ow = cur.O + (size_t)(wid * QBLK) * OS;
#pragma unroll
    for (int r = 0; r < 16; ++r) { const int orow = crow(r, hi);
#pragma unroll
        for (int d0 = 0; d0 < 4; ++d0) { const float v = o[d0][r] * rli[r];
            const float vn = __shfl_xor(v, 1);
            if ((r32 & 1) == 0) *(unsigned*)(Ow + (size_t)orow * OS + d0 * 32 + r32) = cvtpk(v, vn); } }
    __syncthreads();
#undef RESC
#undef KBASE
#undef MASKT
#undef SEAM_K0
#undef HALF_STEP
}
#undef ROW
#undef VMW
#undef VMWN
#undef SLOAD_H
#undef SWRITE_HK
#undef SWRITE_HV
#undef SWRITE_H
#undef KSWZ
#undef SBAR
}

#define XB_TMO      128
#define XB_XCNT(j)  (256  + 64 * (j))
#define XB_XSUB(j)  (1280 + 64 * (j))
#define XB_XGEN(j)  (2304 + 64 * (j))
#define XB_TOP      3328
#define XB_TOPGEN   3392
#define XCD_BAR_WORDS 3456
#define XB_SPIN_CAP (1u << 18)

__device__ __forceinline__ unsigned xb_ld(unsigned* p)              { return __hip_atomic_load(p, __ATOMIC_RELAXED, __HIP_MEMORY_SCOPE_AGENT); }
__device__ __forceinline__ unsigned xb_add(unsigned* p, unsigned v) { return __hip_atomic_fetch_add(p, v, __ATOMIC_RELAXED, __HIP_MEMORY_SCOPE_AGENT); }
__device__ __forceinline__ unsigned xb_xcc_id() { return (unsigned)__builtin_amdgcn_s_getreg((3 << 11) | 20) & 0xFu; }
#define XB_SPIN(cond, bar) do { unsigned _sp = 0; while (cond) { __builtin_amdgcn_s_sleep(1); \
    if ((++_sp & 255u) == 0u) { if (xb_ld(&(bar)[XB_TMO])) break; if (_sp > XB_SPIN_CAP) { atomicAdd(&(bar)[XB_TMO], 1u); break; } } } } while (0)

struct XcdBarrier {
    unsigned* bar; unsigned x;
    volatile LAS unsigned* st;
};

__device__ __forceinline__ XcdBarrier xcd_barrier_post(unsigned* bar, volatile LAS unsigned* st) {
    XcdBarrier b; b.bar = bar; b.x = xb_xcc_id(); b.st = st;
    if (threadIdx.x == 0) (void)xb_add(&bar[XB_XCNT(b.x)], 1u);
    return b;
}
__device__ __forceinline__ void xcd_barrier_complete(unsigned* bar, unsigned x, unsigned& nloc, unsigned& nx) {
    const unsigned G = gridDim.x * gridDim.y * gridDim.z;
    unsigned sum, cnt, mine, sp = 0u;
    for (;;) {
        sum = 0u; cnt = 0u; mine = 0u;
#pragma unroll
        for (unsigned j = 0; j < 16; ++j) { const unsigned c = xb_ld(&bar[XB_XCNT(j)]); sum += c; cnt += (c > 0u) ? 1u : 0u; mine = (j == x) ? c : mine; }
        if (sum == G) break;
        __builtin_amdgcn_s_sleep(1);
        if ((++sp & 255u) == 0u) { if (xb_ld(&bar[XB_TMO])) break; if (sp > XB_SPIN_CAP) { atomicAdd(&bar[XB_TMO], 1u); break; } }
    }
    nloc = mine > 0u ? mine : 1u; nx = cnt > 0u ? cnt : 1u;
}

__device__ __forceinline__ void xcd_barrier(const XcdBarrier& b) {
    asm volatile("s_waitcnt vmcnt(0)" ::: "memory");
    __syncthreads();
    if (threadIdx.x == 0) {
        unsigned* bar = b.bar;
        __builtin_amdgcn_s_waitcnt(0);
        unsigned nloc = b.st[0], nx = b.st[1];
        if (nloc == 0u) { xcd_barrier_complete(bar, b.x, nloc, nx); b.st[0] = nloc; b.st[1] = nx; }
        const unsigned old = xb_add(&bar[XB_XSUB(b.x)], 1u);
        const unsigned gen = old / nloc;
        if (old + 1u == (gen + 1u) * nloc) {
            __builtin_amdgcn_fence(__ATOMIC_RELEASE, "agent");
            asm volatile("s_waitcnt vmcnt(0)" ::: "memory");
            const unsigned og = xb_add(&bar[XB_TOP], 1u);
            const unsigned tg = og / nx;
            if (og + 1u == (tg + 1u) * nx) xb_add(&bar[XB_TOPGEN], 1u);
            else XB_SPIN(xb_ld(&bar[XB_TOPGEN]) == tg, bar);
            __builtin_amdgcn_fence(__ATOMIC_ACQUIRE, "agent");
            xb_add(&bar[XB_XGEN(b.x)], 1u);
            asm volatile("s_waitcnt vmcnt(0)" ::: "memory");
        } else {
            XB_SPIN(xb_ld(&bar[XB_XGEN(b.x)]) == gen, bar);
            __builtin_amdgcn_fence(__ATOMIC_ACQUIRE, "agent");
            asm volatile("s_waitcnt vmcnt(0)" ::: "memory");
        }
    }
    __syncthreads();
}

struct Args { const void* in[15]; float* out; unsigned char* ws; int ph_lo, ph_hi, li, pad; };
struct Frame {
    LAS unsigned char* lds;
    int tid, lane, wave, G;
    int gw, ngw;
};
__device__ __forceinline__ Frame mkframe(LAS unsigned char* lds) {
    Frame F; int t = threadIdx.x; asm volatile("" : "+v"(t));
    F.lds = lds; F.tid = t; F.lane = t & 63; F.wave = __builtin_amdgcn_readfirstlane(t >> 6);
    F.G = gridDim.x; F.gw = blockIdx.x * 8 + F.wave; F.ngw = F.G * 8; return F;
}
__device__ __forceinline__ const CAS Args* argp() { const CAS Args* p = (const CAS Args*)__builtin_amdgcn_kernarg_segment_ptr(); asm volatile("" : "+s"(p)); return p; }
#define ARG_F(ap, i) ((const float*)(ap)->in[i])
#define WS_AT(ap, T, off) ((T*)((ap)->ws + (off)))
enum { I_X = 0, I_C, I_POS, I_ADAW, I_ADAB, I_NORMG, I_FINALG, I_WGU, I_WD, I_PWIN, I_PWGRP, I_PSCALE, I_PWOUT, I_DWIN, I_DWOUT };

__device__ __forceinline__ void p0_ada_item(const Frame& F, int item) {
    const CAS Args* ap = argp(); const float* c_in = ARG_F(ap, I_C); const float* ada_w = ARG_F(ap, I_ADAW); const float* ada_b = ARG_F(ap, I_ADAB); float* ADA = WS_AT(ap, float, WS_ADA);
    LAS float* sc = (LAS float*)F.lds;
    LAS float* red = sc + 4 * DM;
    for (int i = F.tid; i < 4 * DM; i += 512) { const float v = c_in[i]; sc[i] = v / (1.f + __expf(-v)); }
    __syncthreads();
    const int l = item / 72, chunk = item % 72, e0 = chunk * 256 + 4 * F.lane;
    const float* wp = ada_w + ((size_t)l * DM + (size_t)F.wave * 256) * ADA_E + e0;
    f32x4 a0 = {0.f, 0.f, 0.f, 0.f}, a1 = a0, a2 = a0, a3 = a0;
    const LAS float* s0 = sc + F.wave * 256;
#pragma unroll 8
    for (int d = 0; d < 256; ++d) { const f32x4 xv = *(const f32x4*)(wp + (size_t)d * ADA_E);
        a0 += xv * s0[d]; a1 += xv * s0[DM + d]; a2 += xv * s0[2 * DM + d]; a3 += xv * s0[3 * DM + d]; }
    LAS f32x4* rp = (LAS f32x4*)(red + (F.wave * 4) * 256) + F.lane;
    rp[0] = a0; rp[64] = a1; rp[128] = a2; rp[192] = a3;
    __syncthreads();
#pragma unroll
    for (int i = 0; i < 2; ++i) { const int o = F.tid + 512 * i, b = o >> 8, col = o & 255; float s = 0.f;
#pragma unroll
        for (int w = 0; w < 8; ++w) s += red[(w * 4 + b) * 256 + col];
        const int e = chunk * 256 + col;
        ADA[(size_t)(b * 2 + l) * ADA_E + e] = s + ada_b[l * ADA_E + e]; }
    __syncthreads();
}
__device__ __forceinline__ int cvt_pos(int perm, int n) {
    if (perm == 1) return n < 16 ? 2 * n : (n < 32 ? 2 * (n - 16) + 1 : n);
    if (perm == 2) return n < 8 ? 2 * n : (n < 16 ? 2 * (n - 8) + 1 : n);
    return n;
}
__device__ __forceinline__ void cvt_item(const float* W, int Nsrc, int k0, int c0, int nvalid, bf16_t* Bt, int ldb, int drow0, int perm, const float* rscale, LAS unsigned* scr, int lane) {
    const int gq = lane >> 4, q = lane & 15;
    const bool valid = 4 * q < nvalid;
    f32x4 va[8], vb[8];
#pragma unroll
    for (int i = 0; i < 8; ++i) { const int k = k0 + 8 * i + 2 * gq; const float* p = W + (size_t)k * Nsrc + c0 + 4 * q;
        va[i] = valid ? *(const f32x4*)p : (f32x4){0.f, 0.f, 0.f, 0.f}; vb[i] = valid ? *(const f32x4*)(p + Nsrc) : (f32x4){0.f, 0.f, 0.f, 0.f}; }
    int prow[4];
#pragma unroll
    for (int e = 0; e < 4; ++e) prow[e] = cvt_pos(perm, 4 * q + e) * 33;
#pragma unroll
    for (int i = 0; i < 8; ++i) { const int k = k0 + 8 * i + 2 * gq; float sa = 1.f, sb = 1.f;
        if (rscale) { sa = rscale[k]; sb = rscale[k + 1]; }
#pragma unroll
        for (int e = 0; e < 4; ++e) scr[prow[e] + 4 * i + gq] = cvt_pk_bf16(va[i][e] * sa, vb[i][e] * sb); }
    LDS_WAIT(); asm volatile("" ::: "memory");
    const int c = lane & 7;
#pragma unroll
    for (int jj = 0; jj < 8; ++jj) { const int n = (lane >> 3) + 8 * jj; const LAS unsigned* s = scr + n * 33 + 4 * c;
        u32x4 o; o.x = s[0]; o.y = s[1]; o.z = s[2]; o.w = s[3];
        *(u32x4*)(Bt + (size_t)(drow0 + n) * ldb + k0 + 8 * c) = o; }
    LDS_WAIT(); asm volatile("" ::: "memory");
}
constexpr int CV_WGU = 4 * 32 * 176, CV_WD = 4 * 88 * 32, CV_PWIN = 32 * 32, CV_PWGRP = 4 * 8 * 8, CV_PWOUT = 32 * 32, CV_DWIN = 32 * 66, CV_DWOUT = 32 * 32;
constexpr int CV_TOTAL = CV_WGU + CV_WD + CV_PWIN + CV_PWGRP + CV_PWOUT + CV_DWIN + CV_DWOUT;
__device__ __forceinline__ void p0_cvt_dispatch(int it, LAS unsigned* scr, int lane) {
    const CAS Args* ap = argp(); int r = it;
    if (r < CV_WGU) { const int mat = r / (32 * 176); r -= mat * (32 * 176); const int nb = r / 32, kb = r % 32, c0 = 64 * nb;
        const int is_u = c0 >= FF ? 1 : 0, hid = c0 - is_u * FF, drow = 256 * (hid >> 7) + 128 * is_u + (hid & 127);
        cvt_item(ARG_F(ap, I_WGU) + (size_t)mat * DM * 2 * FF, 2 * FF, 64 * kb, c0, 64, WS_AT(ap, bf16_t, WS_WGU) + (size_t)mat * 2 * FF * DM, DM, drow, 0, nullptr, scr, lane); return; }
    r -= CV_WGU;
    if (r < CV_WD) { const int mat = r / (88 * 32); r -= mat * (88 * 32); const int nb = r / 88, kb = r % 88;
        cvt_item(ARG_F(ap, I_WD) + (size_t)mat * FF * DM, DM, 64 * kb, 64 * nb, 64, WS_AT(ap, bf16_t, WS_WD) + (size_t)mat * DM * FF, FF, 64 * nb, 0, nullptr, scr, lane); return; }
    r -= CV_WD;
    if (r < CV_PWIN) { const int nb = r / 32, kb = r % 32; cvt_item(ARG_F(ap, I_PWIN), DM, 64 * kb, 64 * nb, 64, WS_AT(ap, bf16_t, WS_PWIN), DM, 64 * nb, 0, nullptr, scr, lane); return; }
    r -= CV_PWIN;
    if (r < CV_PWGRP) { const int g = r / 64; r -= g * 64; const int nb = r / 8, kb = r % 8;
        cvt_item(ARG_F(ap, I_PWGRP) + (size_t)g * 512 * 512, 512, 64 * kb, 64 * nb, 64, WS_AT(ap, bf16_t, WS_PWGRP), 512, g * 512 + 64 * nb, 0, nullptr, scr, lane); return; }
    r -= CV_PWGRP;
    if (r < CV_PWOUT) { const int nb = r / 32, kb = r % 32; cvt_item(ARG_F(ap, I_PWOUT), DM, 64 * kb, 64 * nb, 64, WS_AT(ap, bf16_t, WS_PWOUT), DM, 64 * nb, 0, ARG_F(ap, I_PSCALE), scr, lane); return; }
    r -= CV_PWOUT;
    if (r < CV_DWIN) { const int nb = r / 32, kb = r % 32, c0 = 64 * nb; int perm = 0, nvalid = 64;
        if (c0 < 2560) perm = ((c0 & 127) == 0) ? 1 : 0; else if (c0 < 3072) perm = 0; else if (c0 < 4160) perm = 2; else { perm = 0; nvalid = 16; }
        cvt_item(ARG_F(ap, I_DWIN), DSA_IN, 64 * kb, c0, nvalid, WS_AT(ap, bf16_t, WS_DWIN), DM, c0, perm, nullptr, scr, lane); return; }
    r -= CV_DWIN;
    { const int nb = r / 32, kb = r % 32; cvt_item(ARG_F(ap, I_DWOUT), DM, 64 * kb, 64 * nb, 64, WS_AT(ap, bf16_t, WS_DWOUT), DM, 64 * nb, 0, nullptr, scr, lane); }
}
__device__ __forceinline__ void p0_prologue(const Frame& F) {
    for (int it = blockIdx.x; it < 144; it += F.G) p0_ada_item(F, it);
    { const CAS Args* ap = argp(); const int* pos = (const int*)ap->in[I_POS]; float* cosq = WS_AT(ap, float, WS_COSQ); float* sinq = WS_AT(ap, float, WS_SINQ); float* cosi = WS_AT(ap, float, WS_COSI); float* sini = WS_AT(ap, float, WS_SINI);
    for (int row = F.gw; row < NTOK; row += F.ngw) {
        if (F.lane < 24) { const float p = (float)pos[row]; const bool isq = F.lane < 16; const int i = isq ? F.lane : F.lane - 16;
            float sn, cs; sincos_acc(p * (isq ? INVF_Q[i] : INVF_I[i]), sn, cs);
            if (isq) { cosq[(size_t)row * 16 + i] = cs; sinq[(size_t)row * 16 + i] = sn; } else { cosi[(size_t)row * 8 + i] = cs; sini[(size_t)row * 8 + i] = sn; } }
    } }
    { const size_t n16 = (size_t)(DSA_NPAD - 4224) * DM * 2 / 16; u32x4* zp = (u32x4*)(WS_AT(argp(), bf16_t, WS_DWIN) + (size_t)4224 * DM);
      for (size_t i = (size_t)blockIdx.x * 512 + F.tid; i < n16; i += (size_t)F.G * 512) zp[i] = (u32x4){0u, 0u, 0u, 0u}; }
    __syncthreads();
    LAS unsigned* scr = (LAS unsigned*)(F.lds + F.wave * 8704);
    for (;;) {
        int it = 0; if (F.lane == 0) it = (int)__hip_atomic_fetch_add(WS_AT(argp(), unsigned, WS_CTL) + CW_QUEUE, 1u, RLX_AGENT);
        it = __builtin_amdgcn_readfirstlane(it);
        if (it >= CV_TOTAL) break;
        p0_cvt_dispatch(it, scr, F.lane);
    }
}

__device__ __forceinline__ void norm_phase(const Frame& F, const float* src, float* cpy, const float* g, const float* mod0  , bf16_t* Y) {
    for (int r0 = 4 * F.gw; r0 < NTOK; r0 += 4 * F.ngw) {
        const int b = r0 / SEQ; const float* mod = mod0 + (size_t)b * 2 * ADA_E;
        f32x4 A[8], Bv[8];
#pragma unroll
        for (int j = 0; j < 8; ++j) { const int col = 4 * F.lane + 256 * j; const f32x4 gv = *(const f32x4*)(g + col), sc = *(const f32x4*)(mod + DM + col);
            A[j] = gv * (sc + 1.0f); Bv[j] = *(const f32x4*)(mod + col); }
        for (int rr = 0; rr < 4; ++rr) { const int row = r0 + rr; const f32x4* xr = (const f32x4*)(src + (size_t)row * DM) + F.lane;
            f32x4 v[8]; float s = 0.f;
#pragma unroll
            for (int j = 0; j < 8; ++j) { v[j] = xr[64 * j]; s += (v[j].x * v[j].x + v[j].y * v[j].y) + (v[j].z * v[j].z + v[j].w * v[j].w); }
            const float rstd = 1.0f / sqrtf(wave_sum(s) * (1.0f / DM) + RMS_EPS);
            if (cpy) { f32x4* cr = (f32x4*)(cpy + (size_t)row * DM) + F.lane;
#pragma unroll
                for (int j = 0; j < 8; ++j) cr[64 * j] = v[j]; }
            u32x2* yr = (u32x2*)(Y + (size_t)row * DM) + F.lane;
#pragma unroll
            for (int j = 0; j < 8; ++j) { const f32x4 o = v[j] * rstd * A[j] + Bv[j]; u32x2 w; w.x = cvt_pk_bf16(o.x, o.y); w.y = cvt_pk_bf16(o.z, o.w); yr[64 * j] = w; } }
    }
}
__device__ __forceinline__ void final_norm_phase(const Frame& F, float* H, const float* g) {
    for (int row = F.gw; row < NTOK; row += F.ngw) { f32x4* xr = (f32x4*)(H + (size_t)row * DM) + F.lane;
        f32x4 v[8]; float s = 0.f;
#pragma unroll
        for (int j = 0; j < 8; ++j) { v[j] = xr[64 * j]; s += (v[j].x * v[j].x + v[j].y * v[j].y) + (v[j].z * v[j].z + v[j].w * v[j].w); }
        const float rstd = 1.0f / sqrtf(wave_sum(s) * (1.0f / DM) + RMS_EPS);
#pragma unroll
        for (int j = 0; j < 8; ++j) xr[64 * j] = v[j] * rstd * *(const f32x4*)(g + 4 * F.lane + 256 * j); }
}
__device__ __forceinline__ void pool_phase(const Frame& F, const bf16_t* U, bf16_t* Pp) {
    for (int task = F.gw; task < NB * 4 * (SEQ / 16); task += F.ngw) {
        const int run = task % (SEQ / 16), g = (task / (SEQ / 16)) & 3, b = task / (4 * (SEQ / 16));
        const int w = 2 << g, t0 = run * 16;
        const bf16_t* ub = U + (size_t)b * SEQ * DM + 512 * g + 8 * F.lane; bf16_t* pb = Pp + (size_t)b * SEQ * DM + 512 * g + 8 * F.lane;
        float s[8];
#pragma unroll
        for (int e = 0; e < 8; ++e) s[e] = 0.f;
        for (int j = (t0 - w + 1 > 0 ? t0 - w + 1 : 0); j < t0; ++j) { const u32x4 x = *(const u32x4*)(ub + (size_t)j * DM);
            s[0] += bf_lo(x.x); s[1] += bf_hi(x.x); s[2] += bf_lo(x.y); s[3] += bf_hi(x.y); s[4] += bf_lo(x.z); s[5] += bf_hi(x.z); s[6] += bf_lo(x.w); s[7] += bf_hi(x.w); }
#pragma unroll 4
        for (int t = t0; t < t0 + 16; ++t) { const u32x4 x = *(const u32x4*)(ub + (size_t)t * DM);
            float u[8] = {bf_lo(x.x), bf_hi(x.x), bf_lo(x.y), bf_hi(x.y), bf_lo(x.z), bf_hi(x.z), bf_lo(x.w), bf_hi(x.w)};
            if (t > t0 && t - w >= 0) { const u32x4 y = *(const u32x4*)(ub + (size_t)(t - w) * DM);
                s[0] -= bf_lo(y.x); s[1] -= bf_hi(y.x); s[2] -= bf_lo(y.y); s[3] -= bf_hi(y.y); s[4] -= bf_lo(y.z); s[5] -= bf_hi(y.z); s[6] -= bf_lo(y.w); s[7] -= bf_hi(y.w); }
            const float inv = 1.0f / (float)((t + 1) < w ? (t + 1) : w);
            float o[8];
#pragma unroll
            for (int e = 0; e < 8; ++e) { s[e] += u[e]; o[e] = s[e] * inv - u[e]; }
            u32x4 wv; wv.x = cvt_pk_bf16(o[0], o[1]); wv.y = cvt_pk_bf16(o[2], o[3]); wv.z = cvt_pk_bf16(o[4], o[5]); wv.w = cvt_pk_bf16(o[6], o[7]);
            *(u32x4*)(pb + (size_t)t * DM) = wv; }
    }
}
__device__ __forceinline__ void dk_phase(const Frame& F) {
    const CAS Args* ap = argp(); const float* KWP = WS_AT(ap, float, WS_BIG + BIG_KWP); const float* cosi = WS_AT(ap, float, WS_COSI); const float* sini = WS_AT(ap, float, WS_SINI);
    bf16_t* KI = WS_AT(ap, bf16_t, WS_KI); float* WI = WS_AT(ap, float, WS_WI);
    const int nthr = F.G * 512;
    for (int i = blockIdx.x * 512 + F.tid; i < NTOK * 20; i += nthr) { const int row = i / 20, q = i % 20;
        f32x4 s = {0.f, 0.f, 0.f, 0.f};
#pragma unroll
        for (int k = 0; k < 8; ++k) s += *(const f32x4*)(KWP + ((size_t)k * NTOK + row) * 128 + 4 * q);
        if (q < 16) {
            if (q < 4) { const float c0 = cosi[(size_t)row * 8 + 2 * q], s0 = sini[(size_t)row * 8 + 2 * q], c1 = cosi[(size_t)row * 8 + 2 * q + 1], s1 = sini[(size_t)row * 8 + 2 * q + 1];
                const f32x4 a = s; s.x = a.x * c0 - a.y * s0; s.y = a.y * c0 + a.x * s0; s.z = a.z * c1 - a.w * s1; s.w = a.w * c1 + a.z * s1; }
            u32x2 w; w.x = cvt_pk_bf16(s.x, s.y); w.y = cvt_pk_bf16(s.z, s.w); *(u32x2*)(KI + (size_t)row * 64 + 4 * q) = w;
        } else *(f32x4*)(WI + (size_t)row * 16 + 4 * (q - 16)) = s;
    }
}

constexpr int MN_PITCH = 65;
constexpr int MN_OFF = RING_BYTES + 1024;
static_assert(MN_OFF + 32 * MN_PITCH * 4 <= LDS_BYTES, "LDS map: select phase");
__device__ __forceinline__ void select_unit(const Frame& F, int b, int grp) {
    const CAS Args* ap = argp(); const bf16_t* QI = WS_AT(ap, bf16_t, WS_BIG + BIG_QI); const bf16_t* KI = WS_AT(ap, bf16_t, WS_KI); const float* WI = WS_AT(ap, float, WS_WI);
    LAS unsigned* MN = (LAS unsigned*)(F.lds + MN_OFF);
    const int lane = F.lane, half = lane >> 5, l31 = lane & 31;
    LAS float* SC = (LAS float*)F.lds + (F.wave * 2 + half) * SEQ + l31;
#pragma unroll 1
    for (int round = 0; round < 2; ++round) {
        const int tok0 = 32 * grp + 16 * round + 2 * F.wave, myt = tok0 + half;
        const int ntile = ((tok0 + 1) >> 5) + 1;
        {
            const int at = (l31 >> 2) & 1, ah = (l31 & 3) + 4 * (l31 >> 3);
            const bf16_t* qp = QI + (size_t)(b * SEQ + tok0 + at) * 1024 + ah * 64 + 8 * half;
            bf16x8 af[4];
#pragma unroll
            for (int s = 0; s < 4; ++s) af[s] = *(const bf16x8*)(qp + 16 * s);
            float wv[16];
            { const f32x4* wp = (const f32x4*)(WI + (size_t)(b * SEQ + myt) * 16);
#pragma unroll
              for (int i = 0; i < 4; ++i) { const f32x4 x = wp[i]; wv[4 * i] = x.x; wv[4 * i + 1] = x.y; wv[4 * i + 2] = x.z; wv[4 * i + 3] = x.w; } }
            const bf16_t* kp = KI + (size_t)(b * SEQ + l31) * 64 + 8 * half;
#pragma unroll 2
            for (int tile = 0; tile < ntile; ++tile) {
                f32x16 acc = {};
#pragma unroll
                for (int s = 0; s < 4; ++s) { const bf16x8 bfr = *(const bf16x8*)(kp + (size_t)tile * 32 * 64 + 16 * s); acc = __builtin_amdgcn_mfma_f32_32x32x16_bf16(af[s], bfr, acc, 0, 0, 0); }
                float t = 0.f;
#pragma unroll
                for (int i = 0; i < 16; ++i) t += wv[i] * fmaxf(acc[i], 0.f);
                SC[32 * tile] = (32 * tile + l31 <= myt) ? t : -__builtin_inff();
            }
        }
        LDS_WAIT(); asm volatile("" ::: "memory");
        float v[64];
#pragma unroll
        for (int i = 0; i < 64; ++i) { const float x = SC[32 * i]; v[i] = (i < ntile) ? x : -__builtin_inff(); }
        float thr = -3.0e38f;
        {
            float mn = 3.0e38f, mx = -3.0e38f;
#pragma unroll
            for (int i = 0; i < 64; ++i) { mx = fmaxf(mx, v[i]); mn = fminf(mn, v[i] == -__builtin_inff() ? 3.0e38f : v[i]); }
#pragma unroll
            for (int o = 1; o < 32; o <<= 1) { mx = fmaxf(mx, __shfl_xor(mx, o)); mn = fminf(mn, __shfl_xor(mn, o)); }
            float lo = mn, hi = mx + fabsf(mx) * 1e-6f + 1e-30f;
            bool done = (myt + 1 <= TOPK);
#pragma unroll 1
            for (int it = 0; it < 64; ++it) {
                if (__all(done)) break;
                const float mid = 0.5f * (lo + hi);
                int c = 0;
#pragma unroll
                for (int i = 0; i < 64; ++i) c += (v[i] >= mid) ? 1 : 0;
#pragma unroll
                for (int o = 1; o < 32; o <<= 1) c += __shfl_xor(c, o);
                if (!done) {
                    if (!(mid > lo && mid < hi)) done = true;
                    else if (c >= TOPK) { lo = mid; if (c == TOPK) done = true; }
                    else hi = mid;
                }
            }
            if (myt + 1 > TOPK) thr = lo;
        }
        unsigned m0 = 0u, m1 = 0u;
#pragma unroll
        for (int i = 0; i < 64; ++i) { const unsigned long long bal = __ballot(v[i] >= thr);
            if (lane == i) { m0 = (unsigned)bal; m1 = (unsigned)(bal >> 32); }
            if ((i & 3) == 3) __builtin_amdgcn_sched_barrier(0); }
        const int trow = 16 * round + 2 * F.wave;
        MN[trow * MN_PITCH + lane] = m0; MN[(trow + 1) * MN_PITCH + lane] = m1;
    }
    __syncthreads();
    unsigned long long* mout = WS_AT(ap, unsigned long long, WS_MASK) + (size_t)((b * 64 + grp) * 32) * 32;
#pragma unroll 1
    for (int j = F.wave; j < 32; j += 8) {
        const unsigned d0 = MN[l31 * MN_PITCH + 2 * j], d1 = MN[l31 * MN_PITCH + 2 * j + 1];
        unsigned wlo = 0u, whi = 0u;
#pragma unroll
        for (int r = 0; r < 16; ++r) { const int cc = (r & 3) + 8 * (r >> 2);
            const unsigned long long b0 = __ballot(((d0 >> (cc + 4 * half)) & 1u) != 0u), b1 = __ballot(((d1 >> (cc + 4 * half)) & 1u) != 0u);
            if (lane == r) { wlo = (unsigned)b0; whi = (unsigned)(b0 >> 32); }
            if (lane == 16 + r) { wlo = (unsigned)b1; whi = (unsigned)(b1 >> 32); }
            if ((r & 1) == 1) __builtin_amdgcn_sched_barrier(0); }
        if (lane < 32) mout[(size_t)j * 32 + lane] = ((unsigned long long)whi << 32) | wlo;
    }
    __syncthreads();
}

constexpr int N_PHASES = 25;
#ifndef MK_KINDS
#define MK_KINDS 0xffff
#endif
#define HAVE(k) (((MK_KINDS) >> (k)) & 1)

__global__ void __launch_bounds__(NWAVES * 64, 2) mk_fwd(Args args) {
    extern __shared__ __attribute__((aligned(16))) unsigned char lds[];
    LAS unsigned char* const ldsp = (LAS unsigned char*)lds;
    for (int u = threadIdx.x; u < (LDS_BYTES - LDSCTL_OFF) / 4; u += NWAVES * 64) ((LAS unsigned*)(ldsp + LDSCTL_OFF))[u] = 0u;
    __syncthreads();
    XcdBarrier bar = xcd_barrier_post((unsigned*)(args.ws + WS_CTL) + CW_BAR + args.li * XCD_BAR_WORDS, (volatile LAS unsigned*)(ldsp + MISC_OFF) + 8);
    const int NG = gridDim.x;

    const int lo = args.ph_lo, hi = args.ph_hi;
    int ph = 0;
#define IN_PH() (lo <= ph && ph < hi)
#define SEAM() do { if (lo <= ph && ph + 1 < hi) xcd_barrier(bar); ++ph; } while (0)
    const int bx = (int)blockIdx.x;
    constexpr long TILE_A = 256L * DM * 2;
#define ADA_AT(ap, l, sub, k) (WS_AT(ap, float, WS_ADA) + (size_t)(l) * ADA_E + ((sub) * 3 + (k)) * DM)

    if (HAVE(0) && IN_PH()) { const Frame F = mkframe(ldsp); p0_prologue(F); }
    SEAM();
#pragma unroll 1
    for (int l = 0; l < 2; ++l) {
#pragma unroll 1
        for (int f = 0; f < 2; ++f) {
            if (f == 1) {
                if (HAVE(1) && IN_PH()) { const CAS Args* ap = argp();
                    const Frame F = mkframe(ldsp); norm_phase(F, ap->out, nullptr, ARG_F(ap, I_NORMG) + (size_t)(l * 3 + 1) * DM, ADA_AT(ap, l, 1, 0), WS_AT(ap, bf16_t, WS_Y)); }
                SEAM();
                if (l == 0) {
                    if (HAVE(4) && IN_PH()) { const CAS Args* ap = argp(); pg8::Gemm g{WS_AT(ap, bf16_t, WS_Y), WS_AT(ap, bf16_t, WS_PWIN), DM, DM, DM}; pg8::StaticOrder S; S.init(32, 8, NG, bx, TILE_A, 0, 0, TILE_A);
                        pg8::EpiBf16 E{WS_AT(ap, bf16_t, WS_BIG + BIG_U), DM}; pg8::gemm_phase<pg8::EpiBf16, pg8::StaticOrder, true, true>(ldsp, g, S, E); }
                    SEAM();
                    if (HAVE(5) && IN_PH()) { const CAS Args* ap = argp(); const Frame F = mkframe(ldsp); pool_phase(F, WS_AT(ap, bf16_t, WS_BIG + BIG_U), WS_AT(ap, bf16_t, WS_BIG + BIG_P)); }
                    SEAM();
                    if (HAVE(6) && IN_PH()) { const CAS Args* ap = argp(); pg8::Gemm g{WS_AT(ap, bf16_t, WS_BIG + BIG_P), WS_AT(ap, bf16_t, WS_PWGRP), DM, 512, 512}; pg8::StaticOrder S; S.init(32, 8, NG, bx, TILE_A, 1, 512 * 2, 256L * 512 * 2);
                        pg8::EpiBf16 E{WS_AT(ap, bf16_t, WS_BIG + BIG_V), DM}; pg8::gemm_phase<pg8::EpiBf16, pg8::StaticOrder, true, true>(ldsp, g, S, E); }
                    SEAM();
                    if (HAVE(7) && IN_PH()) { const CAS Args* ap = argp(); pg8::Gemm g{WS_AT(ap, bf16_t, WS_BIG + BIG_V), WS_AT(ap, bf16_t, WS_PWOUT), DM, DM, DM}; pg8::StaticOrder S; S.init(32, 8, NG, bx, TILE_A, 0, 0, TILE_A);
                        pg8::EpiResid E{ap->out, ADA_AT(ap, l, 1, 2), 1.0f}; pg8::gemm_phase<pg8::EpiResid, pg8::StaticOrder, true, true>(ldsp, g, S, E); }
                    SEAM();
                } else {
                    if (HAVE(8) && IN_PH()) {
                        { const CAS Args* ap = argp(); pg8::Gemm g{WS_AT(ap, bf16_t, WS_Y), WS_AT(ap, bf16_t, WS_DWIN), DM, DM, DM}; pg8::StaticOrder S; S.init(32, 16, NG, bx, TILE_A, 0, 0, TILE_A);
                          pg8::EpiDsaIn E{WS_AT(ap, bf16_t, WS_BIG + BIG_Q), WS_AT(ap, bf16_t, WS_BIG + BIG_K), WS_AT(ap, bf16_t, WS_BIG + BIG_VV), WS_AT(ap, bf16_t, WS_BIG + BIG_QI),
                                              WS_AT(ap, float, WS_COSQ), WS_AT(ap, float, WS_SINQ), WS_AT(ap, float, WS_COSI), WS_AT(ap, float, WS_SINI)};
                          pg8::gemm_phase<pg8::EpiDsaIn, pg8::StaticOrder, true, true>(ldsp, g, S, E); }
                        __syncthreads();
                        { const CAS Args* ap = argp(); pg8::Gemm g{WS_AT(ap, bf16_t, WS_Y), WS_AT(ap, bf16_t, WS_DWIN) + (size_t)4096 * DM, DM, DM, 256}; pg8::StaticOrder S; S.init(32, 8, NG, bx, TILE_A, 0, 256 * 2, 256 * 2);
                          pg8::EpiKW E{WS_AT(ap, float, WS_BIG + BIG_KWP)}; pg8::gemm_phase<pg8::EpiKW, pg8::StaticOrder, true, true>(ldsp, g, S, E); }
                    }
                    SEAM();
                    if (HAVE(9) && IN_PH()) { const Frame F = mkframe(ldsp); dk_phase(F); }
                    SEAM();
                    if (HAVE(10) && IN_PH()) { for (int u = bx; u < NB * 64; u += NG) { const Frame F = mkframe(ldsp); select_unit(F, u >> 6, u & 63); } }
                    SEAM();
                    if (HAVE(11) && IN_PH()) {
                        for (int L = bx; L < 256; L += NG) {
                            const CAS Args* ap = argp();
                            const bf16_t* Qp = WS_AT(ap, bf16_t, WS_BIG + BIG_Q); const bf16_t* Kp = WS_AT(ap, bf16_t, WS_BIG + BIG_K); const bf16_t* Vp = WS_AT(ap, bf16_t, WS_BIG + BIG_VV);
                            bf16_t* Op = WS_AT(ap, bf16_t, WS_O); const unsigned long long* Mp = WS_AT(ap, unsigned long long, WS_MASK);
                            const int xcd = L & 7, k = L >> 3, kvg = 2 * xcd + (k >> 4), r = k & 15, b = kvg >> 2, gk = kvg & 3, h = 4 * gk + (r >> 2), pr = r & 3;
                            attn::BlockRef cur, nxt;
                            { const int qb = pr; const size_t row0 = (size_t)b * SEQ + (size_t)qb * 256;
                              cur.Q = Qp + row0 * DM + h * 128; cur.O = Op + row0 * DM + h * 128; cur.K = Kp + (size_t)b * SEQ * 512 + gk * 128; cur.V = Vp + (size_t)b * SEQ * 512 + gk * 128;
                              cur.M = (attn::cu64p)(Mp + (size_t)((b * 64 + qb * 8) * 32) * 32); cur.P0 = qb * 256; }
                            { const int qb = 7 - pr; const size_t row0 = (size_t)b * SEQ + (size_t)qb * 256;
                              nxt.Q = Qp + row0 * DM + h * 128; nxt.O = Op + row0 * DM + h * 128; nxt.K = cur.K; nxt.V = cur.V;
                              nxt.M = (attn::cu64p)(Mp + (size_t)((b * 64 + qb * 8) * 32) * 32); nxt.P0 = qb * 256; }
                            attn::Seam S;
                            attn::attn_prime(cur, (char*)lds, S);
#pragma unroll 1
                            for (int i = 0; i < 2; ++i) { attn::attn_block(cur, nxt, (char*)lds, S); cur = nxt; }
                        }
                    }
                    SEAM();
                    if (HAVE(12) && IN_PH()) { const CAS Args* ap = argp(); pg8::Gemm g{WS_AT(ap, bf16_t, WS_O), WS_AT(ap, bf16_t, WS_DWOUT), DM, DM, DM}; pg8::StaticOrder S; S.init(32, 8, NG, bx, TILE_A, 0, 0, TILE_A);
                        pg8::EpiResid E{ap->out, ADA_AT(ap, l, 1, 2), 1.0f}; pg8::gemm_phase<pg8::EpiResid, pg8::StaticOrder, true, true>(ldsp, g, S, E); }
                    SEAM();
                }
            }
            const int sub = f == 0 ? 0 : 2;
            if (HAVE(1) && IN_PH()) { const CAS Args* ap = argp(); const bool first = (l == 0 && f == 0); const Frame F = mkframe(ldsp);
                norm_phase(F, first ? ARG_F(ap, I_X) : (const float*)ap->out, first ? ap->out : nullptr, ARG_F(ap, I_NORMG) + (size_t)(l * 3 + sub) * DM, ADA_AT(ap, l, sub, 0), WS_AT(ap, bf16_t, WS_Y)); }
            SEAM();
            if (HAVE(2) && IN_PH()) { const CAS Args* ap = argp(); pg8::Gemm g{WS_AT(ap, bf16_t, WS_Y), WS_AT(ap, bf16_t, WS_WGU) + (size_t)(l * 2 + f) * 2 * FF * DM, DM, DM, DM}; pg8::StaticOrder S; S.init(32, 44, NG, bx, TILE_A, 0, 0, TILE_A);
                pg8::EpiSwiglu E{WS_AT(ap, bf16_t, WS_BIG), FF}; pg8::gemm_phase<pg8::EpiSwiglu, pg8::StaticOrder, true, true>(ldsp, g, S, E); }
            SEAM();
            if (HAVE(3) && IN_PH()) { const CAS Args* ap = argp(); pg8::Gemm g{WS_AT(ap, bf16_t, WS_BIG), WS_AT(ap, bf16_t, WS_WD) + (size_t)(l * 2 + f) * DM * FF, FF, FF, FF}; pg8::StaticOrder S; S.init(32, 8, NG, bx, 256L * FF * 2, 0, 0, 256L * FF * 2);
                pg8::EpiResid E{ap->out, ADA_AT(ap, l, sub, 2), 0.5f}; pg8::gemm_phase<pg8::EpiResid, pg8::StaticOrder, true, true>(ldsp, g, S, E); }
            SEAM();
        }
    }
    if (HAVE(13) && IN_PH()) { const CAS Args* ap = argp(); const Frame F = mkframe(ldsp); final_norm_phase(F, ap->out, ARG_F(ap, I_FINALG)); }
#undef IN_PH
#undef SEAM
}

extern "C" void kernel_launch(void* const* d_in, const int* in_sizes, int n_in, void* d_out, int out_size, void* d_ws, size_t ws_size, hipStream_t stream) {
    static int grid = 0;
    if (grid == 0) {
        if (n_in != 15 || out_size != NTOK * DM || ws_size < WS_END) { fprintf(stderr, "kernel_launch: unexpected shapes (n_in %d, out %d, ws %zu)\n", n_in, out_size, ws_size); grid = -1; return; }
        int dev = 0, cus = 0, per_cu = 0;
        if (hipGetDevice(&dev) != hipSuccess || hipDeviceGetAttribute(&cus, hipDeviceAttributeMultiprocessorCount, dev) != hipSuccess) { grid = -1; return; }
        if (hipFuncSetAttribute((const void*)mk_fwd, hipFuncAttributeMaxDynamicSharedMemorySize, LDS_BYTES) != hipSuccess) { fprintf(stderr, "kernel_launch: hipFuncSetAttribute failed\n"); grid = -1; return; }
        if (hipOccupancyMaxActiveBlocksPerMultiprocessor(&per_cu, (const void*)mk_fwd, NWAVES * 64, LDS_BYTES) != hipSuccess || per_cu < 1) { fprintf(stderr, "kernel_launch: occupancy query says %d\n", per_cu); }
        (void)hipGetLastError();
        grid = cus;
    }
    if (grid < 0) return;
    (void)in_sizes;
    if (hipMemsetAsync((char*)d_ws + WS_CTL, 0, CTL_ZERO_BYTES, stream) != hipSuccess) return;
    Args a{};
    for (int i = 0; i < 15; ++i) a.in[i] = d_in[i];
    a.out = (float*)d_out; a.ws = (unsigned char*)d_ws;
#if MK_N_LAUNCHES == 1
    a.ph_lo = 0; a.ph_hi = N_PHASES; a.li = 0; a.pad = 0;
    hipLaunchKernelGGL(mk_fwd, dim3(grid), dim3(NWAVES * 64), LDS_BYTES, stream, a);
#else
    for (int p = 0; p < N_PHASES; ++p) { a.ph_lo = p; a.ph_hi = p + 1; a.li = 0; a.pad = 0;
        hipLaunchKernelGGL(mk_fwd, dim3(grid), dim3(NWAVES * 64), LDS_BYTES, stream, a); }
#endif
}
```

```cpp
#include <hip/hip_runtime.h>
#include <cstdio>
#include <cstdint>
#ifndef MK_N_LAUNCHES
#define MK_N_LAUNCHES 1
#endif

#define LAS __attribute__((address_space(3)))
#define GAS __attribute__((address_space(1)))
#define CAS __attribute__((address_space(4)))
typedef unsigned short bf16_t;
typedef short bf16x8 __attribute__((ext_vector_type(8)));
typedef short s16x4 __attribute__((ext_vector_type(4)));
typedef float f32x2 __attribute__((ext_vector_type(2)));
typedef float f32x4 __attribute__((ext_vector_type(4)));
typedef float f32x16 __attribute__((ext_vector_type(16)));
typedef unsigned u32x2 __attribute__((ext_vector_type(2)));
typedef unsigned u32x4 __attribute__((ext_vector_type(4)));
typedef GAS unsigned gu32;

constexpr int NB = 4, SEQ = 2048, DM = 2048, NTOK = NB * SEQ, FF = 5632;
constexpr int NHEAD = 16, NKVH = 4, HDIM = 128, IHEAD = 16, IDIM = 64, TOPK = 256;
constexpr int DSA_IN = 4176, DSA_NPAD = 4352;
constexpr float RMS_EPS = 1e-6f;
constexpr int ADA_E = 9 * DM;

constexpr size_t MiB = 1u << 20;
constexpr size_t WS_CTL = 0, CTL_ZERO_BYTES = 1 * MiB;
constexpr size_t WS_ADA = 1 * MiB;
constexpr size_t WS_COSQ = 2 * MiB, WS_SINQ = WS_COSQ + 512 * 1024;
constexpr size_t WS_COSI = 3 * MiB, WS_SINI = WS_COSI + 256 * 1024;
constexpr size_t WS_WI = WS_COSI + 512 * 1024;
constexpr size_t WS_KI = 4 * MiB;
constexpr size_t WS_MASK = 5 * MiB;
constexpr size_t WS_WGU = 8 * MiB;
constexpr size_t WS_WD = WS_WGU + 4 * 44 * MiB;
constexpr size_t WS_PWIN = WS_WD + 4 * 22 * MiB;
constexpr size_t WS_PWGRP = WS_PWIN + 8 * MiB;
constexpr size_t WS_PWOUT = WS_PWGRP + 2 * MiB;
constexpr size_t WS_DWIN = WS_PWOUT + 8 * MiB;
constexpr size_t WS_DWOUT = WS_DWIN + 17 * MiB;
constexpr size_t WS_Y = WS_DWOUT + 8 * MiB + 5 * MiB;
constexpr size_t WS_BIG = WS_Y + 32 * MiB;
constexpr size_t WS_O = WS_BIG + 96 * MiB;
constexpr size_t WS_END = WS_O + 32 * MiB;
static_assert(WS_Y == 320 * MiB, "ws map");
constexpr size_t BIG_U = 0, BIG_P = 32 * MiB, BIG_V = 64 * MiB;
constexpr size_t BIG_Q = 0, BIG_K = 32 * MiB, BIG_VV = 40 * MiB, BIG_QI = 48 * MiB, BIG_KWP = 64 * MiB;

constexpr int CW_TMO = 0, CW_QUEUE = 64, CW_BAR = 4096;

constexpr int RING_BYTES = 131072;
constexpr int LDSCTL_OFF = RING_BYTES, MISC_OFF = LDSCTL_OFF + 320;
constexpr int LDS_BYTES = 147456;
constexpr int NWAVES = 8;

#define LDS_WAIT() asm volatile("s_waitcnt lgkmcnt(0)" ::: "memory")
#define VM_WAIT() asm volatile("s_waitcnt vmcnt(0)" ::: "memory")
#define RLX_AGENT __ATOMIC_RELAXED, __HIP_MEMORY_SCOPE_AGENT

__device__ __forceinline__ unsigned cvt_pk_bf16(float lo, float hi) { unsigned r; asm volatile("v_cvt_pk_bf16_f32 %0, %1, %2" : "=v"(r) : "v"(lo), "v"(hi)); return r; }
__device__ __forceinline__ float bf_lo(unsigned w) { return __uint_as_float(w << 16); }
__device__ __forceinline__ float bf_hi(unsigned w) { return __uint_as_float(w & 0xffff0000u); }
__device__ __forceinline__ float wave_sum(float v) {
#pragma unroll
    for (int o = 1; o < 64; o <<= 1) v += __shfl_xor(v, o);
    return v;
}

__device__ const float INVF_Q[16] = {1.0f, 0.44036659598350525f, 0.1939227432012558f, 0.08539710193872452f, 0.03760603070259094f, 0.01656043902039528f, 0.007292664609849453f, 0.0032114458736032248f,
                                     0.0014142135623842478f, 0.000622772378847003f, 0.00027424818836152554f, 0.00012076973507646471f, 5.318296098266728e-05f, 2.34199997066753e-05f, 1.0313386155758053e-05f, 4.541670477919979e-06f};
__device__ const float INVF_I[8] = {1.0f, 0.1939227432012558f, 0.03760603070259094f, 0.007292664609849453f, 0.0014142135623842478f, 0.00027424818836152554f, 5.318296098266728e-05f, 1.0313386155758053e-05f};

__device__ __forceinline__ void sincos_acc(float xf, float& sn, float& cs) {
    const double x = (double)xf;
    const double q = rint(x * 0.63661977236758134308);
    const double r = fma(-q, 1.57079632679489661923, x) - q * 6.123233995736766e-17;
    const double r2 = r * r;
    double sp = -2.5052108385441720e-08; sp = sp * r2 + 2.7557319223985893e-06; sp = sp * r2 - 1.9841269841269841e-04; sp = sp * r2 + 8.3333333333333332e-03; sp = sp * r2 - 1.6666666666666666e-01;
    const double s = r + r * r2 * sp;
    double cp = 2.0876756987868099e-09; cp = cp * r2 - 2.7557319223985888e-07; cp = cp * r2 + 2.4801587301587302e-05; cp = cp * r2 - 1.3888888888888889e-03; cp = cp * r2 + 4.1666666666666664e-02; cp = cp * r2 - 0.5;
    const double c = 1.0 + r2 * cp;
    const int qi = ((int)q) & 3;
    const double ss = (qi == 0) ? s : (qi == 1) ? c : (qi == 2) ? -s : -c;
    const double cc = (qi == 0) ? c : (qi == 1) ? -s : (qi == 2) ? -c : s;
    sn = (float)ss; cs = (float)cc;
}

namespace pg8 {
#define PG8_LAS __attribute__((address_space(3)))
constexpr int BM = 256, BK = 64, HALF = 128, HTB = HALF * BK * 2, STAGE_BYTES = 8 * HTB, NXCD = 8, WGM = 8;
__host__ __device__ __forceinline__ int lds_byte(int r, int c) { const int st = (r >> 4) * 2 + (c >> 5), rr = r & 15, cc = c & 31, ob = rr * 64 + cc * 2; return st * 1024 + (ob ^ (((ob >> 9) & 1) << 5)); }
__host__ __device__ __forceinline__ void stage_rc(int b, int& R, int& C) { const int st = b / 1024, sb = b % 1024, swz = sb ^ (((sb >> 9) & 1) << 5); R = (st >> 1) * 16 + swz / 64; C = (st & 1) * 32 + (swz % 64) / 2; }
__host__ __device__ __forceinline__ int perm32(int rho) { const int n = rho >> 4, i = rho & 15; return 8 * (i >> 2) + 4 * n + (i & 3); }

struct Unit { int pm, pn; long aoff, boff; };
struct Gemm { const bf16_t* A; const bf16_t* Bt; int lda, ldb, K; };

struct StaticOrder {
    int nM, nN, nwg, G, c, a_sh; long a_m, a_n, b_n;
    __device__ void init(int nM_, int nN_, int G_, int c_, long a_m_, int a_sh_, long a_n_, long b_n_) { nM = nM_; nN = nN_; nwg = nM * nN; G = G_; c = c_; a_m = a_m_; a_sh = a_sh_; a_n = a_n_; b_n = b_n_; }
    __device__ bool next(int i, Unit& u) const {
        const long L = (long)i * G + c; if (L >= nwg) return false;
        int wgid = (int)L; { const int q = nwg / NXCD, r = nwg % NXCD, xcd = wgid % NXCD, off = wgid / NXCD; wgid = (xcd < r ? xcd * (q + 1) : r * (q + 1) + (xcd - r) * q) + off; }
        const int nig = WGM * nN, gid = wgid / nig, fm = gid * WGM, gsz = (nM - fm) < WGM ? (nM - fm) : WGM;
        u.pm = fm + ((wgid % nig) % gsz); u.pn = (wgid % nig) / gsz;
        u.aoff = (long)u.pm * a_m + (long)(u.pn >> a_sh) * a_n; u.boff = (long)u.pn * b_n; return true;
    }
    __device__ __forceinline__ void a_ready(const Unit&) const {}
    __device__ __forceinline__ void done(const Unit&) const {}
};

__device__ __forceinline__ u32x4 pack8(const f32x4& v0, const f32x4& v1) { u32x4 w; w.x = cvt_pk_bf16(v0[0], v0[1]); w.y = cvt_pk_bf16(v0[2], v0[3]); w.z = cvt_pk_bf16(v1[0], v1[1]); w.w = cvt_pk_bf16(v1[2], v1[3]); return w; }

struct EpiBf16 {
    static constexpr bool PERM = true, AFTER_DRAIN = false;
    bf16_t* O; int ldc;
    __device__ __forceinline__ void operator()(const f32x4 (&acc)[2][2][4][2], const Unit& u, int wr, int wc, int fr, int fq) const {
        const int row0 = u.pm * BM + wr * 64 + fr, col0 = u.pn * BM + wc * 32 + 8 * fq;
#pragma unroll
        for (int ai = 0; ai < 2; ++ai)
#pragma unroll
            for (int m = 0; m < 4; ++m) { bf16_t* rowp = O + (size_t)(row0 + ai * HALF + m * 16) * ldc + col0;
#pragma unroll
                for (int bj = 0; bj < 2; ++bj) *(u32x4*)(rowp + bj * HALF) = pack8(acc[ai][bj][m][0], acc[ai][bj][m][1]); }
    }
};
struct EpiSwiglu {
    static constexpr bool PERM = true, AFTER_DRAIN = false;
    bf16_t* O; int ldc;
    __device__ __forceinline__ void operator()(const f32x4 (&acc)[2][2][4][2], const Unit& u, int wr, int wc, int fr, int fq) const {
        const int row0 = u.pm * BM + wr * 64 + fr, col0 = u.pn * HALF + wc * 32 + 8 * fq;
#pragma unroll
        for (int ai = 0; ai < 2; ++ai)
#pragma unroll
            for (int m = 0; m < 4; ++m) {
                f32x4 o[2];
#pragma unroll
                for (int n = 0; n < 2; ++n)
#pragma unroll
                    for (int e = 0; e < 4; ++e) { const float g = acc[ai][0][m][n][e], uu = acc[ai][1][m][n][e];
                        o[n][e] = g * uu * __builtin_amdgcn_rcpf(1.0f + __builtin_amdgcn_exp2f(-1.4426950408889634f * g)); }
                *(u32x4*)(O + (size_t)(row0 + ai * HALF + m * 16) * ldc + col0) = pack8(o[0], o[1]); }
    }
};
struct EpiResid {
    static constexpr bool PERM = false, AFTER_DRAIN = false;
    float* H; const float* gate0; float coef;
    __device__ __forceinline__ void operator()(const f32x4 (&acc)[2][2][4][2], const Unit& u, int wr, int wc, int fr, int fq) const {
        const int row0 = u.pm * BM + wr * 64 + fr, col0 = u.pn * BM + wc * 32 + 4 * fq;
        const float* gp = gate0 + (size_t)(u.pm >> 3) * (2 * ADA_E) + col0;
        f32x4 gv[2][2];
#pragma unroll
        for (int bj = 0; bj < 2; ++bj)
#pragma unroll
            for (int n = 0; n < 2; ++n) gv[bj][n] = *(const f32x4*)(gp + bj * HALF + n * 16) * coef;
#pragma unroll
        for (int ai = 0; ai < 2; ++ai)
#pragma unroll
            for (int m = 0; m < 4; ++m) { float* rowp = H + (size_t)(row0 + ai * HALF + m * 16) * DM + col0;
#pragma unroll
                for (int bj = 0; bj < 2; ++bj)
#pragma unroll
                    for (int n = 0; n < 2; ++n) { f32x4* p = (f32x4*)(rowp + bj * HALF + n * 16); *p = *p + gv[bj][n] * acc[ai][bj][m][n]; }
                if (m & 1) asm volatile("" ::: "memory"); }
    }
};
struct EpiDsaIn {
    static constexpr bool PERM = true, AFTER_DRAIN = false;
    bf16_t *Q, *K, *V, *QI; const float *cosq, *sinq, *cosi, *sini;
    __device__ __forceinline__ void operator()(const f32x4 (&acc)[2][2][4][2], const Unit& u, int wr, int wc, int fr, int fq) const {
        const int row0 = u.pm * BM + wr * 64 + fr, pn = u.pn;
        bf16_t* base; int ldc, colt; int mode;
        if (pn < 8) { base = Q; ldc = DM; colt = pn * BM; mode = (wc == 0) ? 1 : 0; }
        else if (pn < 10) { base = K; ldc = 512; colt = (pn - 8) * BM; mode = (wc == 0) ? 1 : 0; }
        else if (pn < 12) { base = V; ldc = 512; colt = (pn - 10) * BM; mode = 0; }
        else { base = QI; ldc = 1024; colt = (pn - 12) * BM; mode = ((wc & 1) == 0 && fq < 2) ? 2 : 0; }
        const int col0 = colt + wc * 32 + 8 * fq;
#pragma unroll
        for (int ai = 0; ai < 2; ++ai)
#pragma unroll
            for (int m = 0; m < 4; ++m) { const int row = row0 + ai * HALF + m * 16;
                f32x4 cs = {1.f, 1.f, 1.f, 1.f}, sn = {0.f, 0.f, 0.f, 0.f};
                if (mode == 1) { cs = *(const f32x4*)(cosq + (size_t)row * 16 + 4 * fq); sn = *(const f32x4*)(sinq + (size_t)row * 16 + 4 * fq); }
                else if (mode == 2) { cs = *(const f32x4*)(cosi + (size_t)row * 8 + 4 * fq); sn = *(const f32x4*)(sini + (size_t)row * 8 + 4 * fq); }
#pragma unroll
                for (int bj = 0; bj < 2; ++bj) { const f32x4 a = acc[ai][bj][m][0], b = acc[ai][bj][m][1]; f32x4 oa, ob;
                    oa[0] = a[0] * cs[0] - a[1] * sn[0]; oa[1] = a[1] * cs[0] + a[0] * sn[0]; oa[2] = a[2] * cs[1] - a[3] * sn[1]; oa[3] = a[3] * cs[1] + a[2] * sn[1];
                    ob[0] = b[0] * cs[2] - b[1] * sn[2]; ob[1] = b[1] * cs[2] + b[0] * sn[2]; ob[2] = b[2] * cs[3] - b[3] * sn[3]; ob[3] = b[3] * cs[3] + b[2] * sn[3];
                    *(u32x4*)(base + (size_t)row * ldc + col0 + bj * HALF) = pack8(oa, ob); } }
    }
};
struct EpiKW {
    static constexpr bool PERM = false, AFTER_DRAIN = false;
    float* P;
    __device__ __forceinline__ void operator()(const f32x4 (&acc)[2][2][4][2], const Unit& u, int wr, int wc, int fr, int fq) const {
        const int row0 = u.pm * BM + wr * 64 + fr, col0 = wc * 32 + 4 * fq;
        float* pb = P + (size_t)u.pn * NTOK * 128;
#pragma unroll
        for (int ai = 0; ai < 2; ++ai)
#pragma unroll
            for (int m = 0; m < 4; ++m) { float* rowp = pb + (size_t)(row0 + ai * HALF + m * 16) * 128 + col0;
#pragma unroll
                for (int n = 0; n < 2; ++n) *(f32x4*)(rowp + n * 16) = acc[ai][0][m][n]; }
    }
};

template <class Epi, class Sched, bool ALIGN_EPI = false, bool SP2 = false>
__device__ __forceinline__ void gemm_phase(PG8_LAS unsigned char* lds, const Gemm g, const Sched& S, const Epi& E) {
    int tid_ = threadIdx.x; asm volatile("" : "+v"(tid_));
    const int tid = tid_, wid = __builtin_amdgcn_readfirstlane(tid >> 6), lane = tid & 63, wr = wid >> 2, wc = wid & 3, fr = lane & 15, fq = lane >> 4;
    const int K = g.K, nt = K / BK;
    unsigned voffA[2], voffB[2];
#pragma unroll
    for (int i = 0; i < 2; ++i) { int R, C; stage_rc(tid * 16 + i * 8192, R, C); const int Rb = Epi::PERM ? ((R & ~31) + perm32(R & 31)) : R;
        voffA[i] = (unsigned)(R * g.lda + C) * 2u; voffB[i] = (unsigned)(Rb * g.ldb + C) * 2u; }
    const size_t kstep = (size_t)(BK * 2);
    const size_t hstepA = (size_t)HALF * g.lda * 2, hstepB = (size_t)HALF * g.ldb * 2;
    const unsigned ldsw = (unsigned)wid * 1024u;
    const int aoff = lds_byte(wr * 64 + fr, fq * 8), boff = lds_byte(wc * 32 + fr, fq * 8);
#define PG8_SA(b, h) (((b) * 2 + (h)) * HTB)
#define PG8_SB(b, h) ((4 + (b) * 2 + (h)) * HTB)
#define PG8_STAGE(bufoff, gbase, voff) do { _Pragma("unroll") for (int _i = 0; _i < 2; ++_i) \
        __builtin_amdgcn_global_load_lds((const unsigned*)((const char*)(gbase) + (voff)[_i]), (PG8_LAS unsigned*)(lds + (bufoff) + ldsw + _i * 8192), 16, 0, 0); } while (0)
#define PG8_LDA(dst, b, h) do { _Pragma("unroll") for (int m = 0; m < 4; ++m) _Pragma("unroll") for (int k = 0; k < 2; ++k) dst[m][k] = *(const PG8_LAS bf16x8*)(lds + PG8_SA(b, h) + aoff + m * 2048 + k * 1024); } while (0)
#define PG8_LDB(dst, b, h) do { _Pragma("unroll") for (int n = 0; n < 2; ++n) _Pragma("unroll") for (int k = 0; k < 2; ++k) dst[n][k] = *(const PG8_LAS bf16x8*)(lds + PG8_SB(b, h) + boff + n * 2048 + k * 1024); } while (0)
#define PG8_MMA(ai, bj, At, Bt) do { __builtin_amdgcn_s_setprio(1); _Pragma("unroll") for (int m = 0; m < 4; ++m) _Pragma("unroll") for (int n = 0; n < 2; ++n) _Pragma("unroll") for (int k = 0; k < 2; ++k) \
        acc[ai][bj][m][n] = __builtin_amdgcn_mfma_f32_16x16x32_bf16(Bt[n][k], At[m][k], acc[ai][bj][m][n], 0, 0, 0); __builtin_amdgcn_s_setprio(0); } while (0)
#define PG8_WAIT_V(n) asm volatile("s_waitcnt vmcnt(" #n ")" ::: "memory")
#define PG8_WAIT_L(n) asm volatile("s_waitcnt lgkmcnt(" #n ")" ::: "memory")
#define PG8_BAR __builtin_amdgcn_s_barrier()
#define PG8_SCHED __builtin_amdgcn_sched_barrier(0)
    Unit cur, nxt; int ui = 0;
    if (!S.next(0, cur)) return;
    f32x4 acc[2][2][4][2];
#pragma unroll
    for (int a = 0; a < 2; ++a)
#pragma unroll
        for (int b = 0; b < 2; ++b)
#pragma unroll
            for (int m = 0; m < 4; ++m)
#pragma unroll
                for (int n = 0; n < 2; ++n) acc[a][b][m][n] = (f32x4){0.f, 0.f, 0.f, 0.f};
    bf16x8 At[4][2], B0[2][2], B1[2][2];
    const char* cA = (const char*)g.A + cur.aoff; const char* cB = (const char*)g.Bt + cur.boff;
    S.a_ready(cur);
    if constexpr (SP2) {
        PG8_STAGE(PG8_SB(0, 0), cB, voffB); PG8_STAGE(PG8_SB(0, 1), cB + hstepB, voffB); PG8_STAGE(PG8_SA(0, 0), cA, voffA); PG8_STAGE(PG8_SA(0, 1), cA + hstepA, voffA);
        if (wr == 1) PG8_BAR;
        PG8_WAIT_V(2); PG8_BAR;
        PG8_STAGE(PG8_SB(1, 0), cB + kstep, voffB); PG8_STAGE(PG8_SA(1, 0), cA + kstep, voffA); PG8_STAGE(PG8_SB(1, 1), cB + hstepB + kstep, voffB);
        PG8_WAIT_V(6); PG8_BAR;
    } else {
        PG8_STAGE(PG8_SB(0, 0), cB, voffB); PG8_STAGE(PG8_SA(0, 0), cA, voffA); PG8_STAGE(PG8_SB(0, 1), cB + hstepB, voffB); PG8_STAGE(PG8_SA(0, 1), cA + hstepA, voffA);
        if (wr == 1) PG8_BAR;
        PG8_WAIT_V(4); PG8_BAR;
        PG8_STAGE(PG8_SB(1, 0), cB + kstep, voffB); PG8_STAGE(PG8_SA(1, 0), cA + kstep, voffA); PG8_STAGE(PG8_SB(1, 1), cB + hstepB + kstep, voffB);
        PG8_WAIT_V(6); PG8_BAR;
    }
    for (;;) {
        const bool has_next = S.next(ui + 1, nxt);
        const char* nA = has_next ? (const char*)g.A + nxt.aoff : cA; const char* nB = has_next ? (const char*)g.Bt + nxt.boff : cB;
        for (int t = 0; t < nt; t += 2) {
            const bool last = (t == nt - 2);
            const char* a1 = cA + (size_t)(t + 1) * kstep;
            const char* a2 = last ? nA : cA + (size_t)(t + 2) * kstep; const char* b2 = last ? nB : cB + (size_t)(t + 2) * kstep;
            const char* a3 = a2 + kstep; const char* b3 = b2 + kstep;
            if (last && has_next) S.a_ready(nxt);
            if constexpr (SP2) {
            PG8_LDB(B0, 0, 0); PG8_LDB(B1, 0, 1); PG8_SCHED; PG8_LDA(At, 0, 0); PG8_STAGE(PG8_SA(1, 1), a1 + hstepA, voffA);
            PG8_WAIT_V(8); PG8_WAIT_L(0); PG8_BAR; PG8_MMA(0, 0, At, B0); PG8_MMA(0, 1, At, B1); PG8_BAR; PG8_SCHED;
            PG8_LDA(At, 0, 1); PG8_STAGE(PG8_SB(0, 0), b2, voffB); PG8_STAGE(PG8_SB(0, 1), b2 + hstepB, voffB); PG8_STAGE(PG8_SA(0, 0), a2, voffA);
            PG8_WAIT_V(8); PG8_WAIT_L(0); PG8_BAR; PG8_MMA(1, 0, At, B0); PG8_MMA(1, 1, At, B1); PG8_BAR; PG8_SCHED;
            PG8_LDB(B0, 1, 0); PG8_LDB(B1, 1, 1); PG8_SCHED; PG8_LDA(At, 1, 0); PG8_STAGE(PG8_SA(0, 1), a2 + hstepA, voffA);
            PG8_WAIT_V(8); PG8_WAIT_L(0); PG8_BAR; PG8_MMA(0, 0, At, B0); PG8_MMA(0, 1, At, B1); PG8_BAR; PG8_SCHED;
            PG8_LDA(At, 1, 1); PG8_STAGE(PG8_SB(1, 0), b3, voffB); PG8_STAGE(PG8_SB(1, 1), b3 + hstepB, voffB); PG8_STAGE(PG8_SA(1, 0), a3, voffA);
            PG8_WAIT_V(8); PG8_WAIT_L(0); PG8_BAR; PG8_MMA(1, 0, At, B0); PG8_MMA(1, 1, At, B1); PG8_BAR; PG8_SCHED;
            } else {
            PG8_LDB(B0, 0, 0); PG8_SCHED; PG8_LDA(At, 0, 0); PG8_STAGE(PG8_SA(1, 1), a1 + hstepA, voffA);
            PG8_WAIT_L(8); PG8_BAR; PG8_WAIT_L(0); PG8_MMA(0, 0, At, B0); PG8_BAR; PG8_SCHED;
            PG8_LDB(B1, 0, 1); PG8_STAGE(PG8_SB(0, 0), b2, voffB);
            PG8_BAR; PG8_WAIT_L(0); PG8_MMA(0, 1, At, B1); PG8_BAR;
            PG8_LDA(At, 0, 1); PG8_STAGE(PG8_SA(0, 0), a2, voffA);
            PG8_BAR; PG8_WAIT_L(0); PG8_MMA(1, 0, At, B0); PG8_BAR; PG8_SCHED;
            PG8_STAGE(PG8_SB(0, 1), b2 + hstepB, voffB);
            PG8_WAIT_V(6); PG8_BAR; PG8_MMA(1, 1, At, B1); PG8_BAR;
            PG8_LDB(B0, 1, 0); PG8_SCHED; PG8_LDA(At, 1, 0); PG8_STAGE(PG8_SA(0, 1), a2 + hstepA, voffA);
            PG8_WAIT_L(8); PG8_BAR; PG8_WAIT_L(0); PG8_MMA(0, 0, At, B0); PG8_BAR; PG8_SCHED;
            PG8_LDB(B1, 1, 1); PG8_STAGE(PG8_SB(1, 0), b3, voffB);
            PG8_BAR; PG8_WAIT_L(0); PG8_MMA(0, 1, At, B1); PG8_BAR;
            PG8_LDA(At, 1, 1); PG8_STAGE(PG8_SA(1, 0), a3, voffA);
            PG8_BAR; PG8_WAIT_L(0); PG8_MMA(1, 0, At, B0); PG8_BAR; PG8_SCHED;
            PG8_STAGE(PG8_SB(1, 1), b3 + hstepB, voffB);
            PG8_WAIT_V(6); PG8_BAR; PG8_MMA(1, 1, At, B1); PG8_BAR;
            }
        }
        if constexpr (ALIGN_EPI) { if (wr == 0) PG8_BAR; }
        if constexpr (!Epi::AFTER_DRAIN) { E(acc, cur, wr, wc, fr, fq); S.done(cur); }
        if (!has_next) break;
#pragma unroll
        for (int a = 0; a < 2; ++a)
#pragma unroll
            for (int b = 0; b < 2; ++b)
#pragma unroll
                for (int m = 0; m < 4; ++m)
#pragma unroll
                    for (int n = 0; n < 2; ++n) acc[a][b][m][n] = (f32x4){0.f, 0.f, 0.f, 0.f};
        cur = nxt; cA = nA; cB = nB; ++ui;
        if constexpr (ALIGN_EPI) { if (wr == 1) PG8_BAR; }
    }
    PG8_WAIT_V(0);
    if constexpr (!ALIGN_EPI) { if (wr == 0) PG8_BAR; }
    PG8_BAR;
    if constexpr (Epi::AFTER_DRAIN) { E.fused(acc, cur, wr, wc, fr, fq, lds, wid, lane); S.done(cur); }
#undef PG8_SA
#undef PG8_SB
#undef PG8_STAGE
#undef PG8_LDA
#undef PG8_LDB
#undef PG8_MMA
#undef PG8_WAIT_V
#undef PG8_WAIT_L
#undef PG8_BAR
#undef PG8_SCHED
}
}

namespace attn {
constexpr int D = 128, QS = 2048, KS = 512, OS = 2048;
constexpr float SCALE = 0.08838834764831845f;
constexpr float THR = 8.f;
constexpr int NW = 8, QBLK = 32, KVBLK = 64, QB = NW * QBLK;
constexpr int SHM_V = KVBLK * D * 2, SHM_K = KVBLK * D * 2;
constexpr int ATT_LDS = 2 * SHM_V + 2 * SHM_K + NW * 64 * 4;
typedef const CAS unsigned long long* cu64p;

#define KSWZ(row, colB) ((row) * 256 + ((colB) ^ (((row) & 7) << 4)))
#define SBAR() __builtin_amdgcn_sched_barrier(0)
__device__ __forceinline__ int v_st(int k, int c) { const int kk = (k & ~0xC) | ((k & 4) << 1) | ((k & 8) >> 1); return ((kk >> 3) * 4 + (c >> 5)) * 512 + ((kk & 7) * 32 + (c & 31)) * 2; }
__device__ __forceinline__ int v_rd_base(int lane) { return ((lane & 3) << 3) | (((lane >> 2) & 3) << 6) | (((lane >> 4) & 1) << 5) | (((lane >> 5) & 1) << 8); }
constexpr int v_rd_off(int d0, int ks, int half) { return d0 * 512 + ks * 4096 + half * 2048; }
__device__ __forceinline__ int crow(int r, int hi) { return (r & 3) + 8 * (r >> 2) + 4 * hi; }
__device__ __forceinline__ unsigned cvtpk(float lo, float hi) { unsigned r; asm volatile("v_cvt_pk_bf16_f32 %0, %1, %2" : "=v"(r) : "v"(lo), "v"(hi)); return r; }
__device__ __forceinline__ bf16x8 load8(const bf16_t* p) { return *reinterpret_cast<const bf16x8*>(p); }

__device__ __forceinline__ void mask_sel(f32x16& p0, f32x16& p1, cu64p mw) {
    const float NEG = -__builtin_inff();
#pragma unroll
    for (int r = 0; r < 16; ++r) { const unsigned long long w0 = mw[r]; p0[r] = __builtin_amdgcn_inverse_ballot_w64(w0) ? p0[r] : NEG; }
    __builtin_amdgcn_sched_barrier(0);
#pragma unroll
    for (int r = 0; r < 16; ++r) { const unsigned long long w1 = mw[16 + r]; p1[r] = __builtin_amdgcn_inverse_ballot_w64(w1) ? p1[r] : NEG; }
}
__device__ __forceinline__ void partialSM(f32x16& p0, f32x16& p1, float& m_reg, float& mn, float& alpha) {
    float pmax = p0[0];
#pragma unroll
    for (int r = 1; r < 16; ++r) pmax = fmaxf(pmax, p0[r]);
#pragma unroll
    for (int r = 0; r < 16; ++r) pmax = fmaxf(pmax, p1[r]);
    { auto rr = __builtin_amdgcn_permlane32_swap(__float_as_uint(pmax), __float_as_uint(pmax), false, false);
      pmax = fmaxf(__uint_as_float(rr[0]), __uint_as_float(rr[1])); }
    constexpr float C2 = 1.4426950408889634f * SCALE;
    if (__builtin_expect(__all((pmax - m_reg) * SCALE <= THR), 1)) { mn = m_reg; alpha = 1.f; }
    else { mn = fmaxf(m_reg, pmax); alpha = __builtin_amdgcn_exp2f((m_reg - mn) * C2); m_reg = mn; }
    const float mnL = -mn * C2;
#pragma unroll
    for (int r = 0; r < 16; ++r) p0[r] = fmaf(p0[r], C2, mnL);
#pragma unroll
    for (int r = 0; r < 16; ++r) p1[r] = fmaf(p1[r], C2, mnL);
#pragma unroll
    for (int r = 0; r < 16; ++r) p0[r] = __builtin_amdgcn_exp2f(p0[r]);
}
__device__ __forceinline__ void finishSM(f32x16& p0, f32x16& p1, float alpha, float& l_reg, bf16x8& pa0, bf16x8& pa1, bf16x8& pa2, bf16x8& pa3) {
#pragma unroll
    for (int r = 0; r < 16; ++r) p1[r] = __builtin_amdgcn_exp2f(p1[r]);
    float ps = 0;
#pragma unroll
    for (int r = 0; r < 16; ++r) ps += p0[r];
#pragma unroll
    for (int r = 0; r < 16; ++r) ps += p1[r];
    { auto rr = __builtin_amdgcn_permlane32_swap(__float_as_uint(ps), __float_as_uint(ps), false, false);
      ps = __uint_as_float(rr[0]) + __uint_as_float(rr[1]); }
    l_reg = l_reg * alpha + ps;
#define PK4(P, B_, OUT) do { unsigned a0 = cvtpk(P[B_+0], P[B_+1]), a1 = cvtpk(P[B_+2], P[B_+3]);                          \
        unsigned b0 = cvtpk(P[B_+4], P[B_+5]), b1 = cvtpk(P[B_+6], P[B_+7]);                                             \
        auto r0 = __builtin_amdgcn_permlane32_swap(a0, b0, false, false); auto r1 = __builtin_amdgcn_permlane32_swap(a1, b1, false, false); \
        u32x4 w = {r0[0], r1[0], r0[1], r1[1]}; OUT = *reinterpret_cast<bf16x8*>(&w); } while (0)
    PK4(p0, 0, pa0); PK4(p0, 8, pa1); PK4(p1, 0, pa2); PK4(p1, 8, pa3);
#undef PK4
}
template <int KB>
__device__ __forceinline__ void qkt(f32x16& p0, f32x16& p1, const char* K_lds, int r32, int hi, const bf16x8* qr) {
    p0 = f32x16{}; p1 = f32x16{};
    const char* kb[4];
#pragma unroll
    for (int dd = 0; dd < 4; ++dd) kb[dd] = K_lds + KB * SHM_K + KSWZ(r32, (dd * 16 + hi * 8) * 2);
#pragma unroll
    for (int d0 = 0; d0 < 8; ++d0) { const char* a = kb[d0 & 3] + (d0 >> 2) * 128;
        bf16x8 b0 = *reinterpret_cast<const bf16x8*>(a);
        bf16x8 b1 = *reinterpret_cast<const bf16x8*>(a + 32 * 256);
        p0 = __builtin_amdgcn_mfma_f32_32x32x16_bf16(b0, qr[d0], p0, 0, 0, 0);
        p1 = __builtin_amdgcn_mfma_f32_32x32x16_bf16(b1, qr[d0], p1, 0, 0, 0); }
}
template <int VB>
__device__ __forceinline__ void pv_tile(f32x16* o, int vb0, bf16x8 pa0, bf16x8 pa1, bf16x8 pa2, bf16x8 pa3) {
#define TRRD(dst, off) asm volatile("ds_read_b64_tr_b16 %0, %1 offset:%2" : "=&v"(dst) : "v"(vb0), "i"(off) : "memory")
#define PV_D0(d0) do { s16x4 l0, l1, l2, l3, h0, h1, h2, h3; constexpr int b_ = VB * SHM_V + v_rd_off(d0, 0, 0); \
        TRRD(l0, b_); TRRD(h0, b_ + 2048); TRRD(l1, b_ + 4096); TRRD(h1, b_ + 6144); TRRD(l2, b_ + 8192); TRRD(h2, b_ + 10240); TRRD(l3, b_ + 12288); TRRD(h3, b_ + 14336); \
        asm volatile("s_waitcnt lgkmcnt(0)" ::: "memory"); SBAR();   \
        o[d0] = __builtin_amdgcn_mfma_f32_32x32x16_bf16(pa0, (bf16x8){l0[0], l0[1], l0[2], l0[3], h0[0], h0[1], h0[2], h0[3]}, o[d0], 0, 0, 0);   \
        o[d0] = __builtin_amdgcn_mfma_f32_32x32x16_bf16(pa1, (bf16x8){l1[0], l1[1], l1[2], l1[3], h1[0], h1[1], h1[2], h1[3]}, o[d0], 0, 0, 0);   \
        o[d0] = __builtin_amdgcn_mfma_f32_32x32x16_bf16(pa2, (bf16x8){l2[0], l2[1], l2[2], l2[3], h2[0], h2[1], h2[2], h2[3]}, o[d0], 0, 0, 0);   \
        o[d0] = __builtin_amdgcn_mfma_f32_32x32x16_bf16(pa3, (bf16x8){l3[0], l3[1], l3[2], l3[3], h3[0], h3[1], h3[2], h3[3]}, o[d0], 0, 0, 0); } while (0)
    PV_D0(0); PV_D0(1); PV_D0(2); PV_D0(3);
#undef PV_D0
#undef TRRD
}

struct BlockRef { const bf16_t* Q; const bf16_t* K; const bf16_t* V; bf16_t* O; cu64p M; int P0; };
struct Seam { bf16x8 qr[8]; bf16x8 st_v0, st_v1, st_k0, st_k1; };
#define ROW(p, k0, rr) ((p) + (size_t)((k0) + (rr)) * KS + sc)
#define VMW() asm volatile("s_waitcnt vmcnt(0)" ::: "memory")
#define VMWN(n) asm volatile("s_waitcnt vmcnt(%0)" :: "i"(n) : "memory")
#define SLOAD_H(Kp, Vp, k0) do { S.st_v0 = load8(ROW(Vp, k0, sr)); S.st_v1 = load8(ROW(Vp, k0, 32 + sr));              \
                         S.st_k0 = load8(ROW(Kp, k0, sr)); S.st_k1 = load8(ROW(Kp, k0, 32 + sr)); } while (0)
#define SWRITE_HK(bf) do { *(bf16x8*)(K_lds + (bf) * SHM_K + kws) = S.st_k0; *(bf16x8*)(K_lds + (bf) * SHM_K + kws + 32 * 256) = S.st_k1; } while (0)
#define SWRITE_HV(bf) do { *(bf16x8*)(V_lds + (bf) * SHM_V + vst0) = S.st_v0; *(bf16x8*)(V_lds + (bf) * SHM_V + vst1) = S.st_v1; } while (0)
#define SWRITE_H(bf) do { SWRITE_HV(bf); SWRITE_HK(bf); } while (0)
__device__ __forceinline__ void attn_prime(const BlockRef& cur, char* lds, Seam& S) {
    int tid_ = threadIdx.x; asm volatile("" : "+v"(tid_));
    const int tid = tid_, wid = __builtin_amdgcn_readfirstlane(tid >> 6), lane = tid & 63, r32 = lane & 31, hi = lane >> 5;
    const int sr = tid >> 4, sc = (tid & 15) * 8, kws = KSWZ(sr, sc * 2); char* K_lds = lds + 2 * SHM_V;
#pragma unroll
    for (int d0 = 0; d0 < 8; ++d0) S.qr[d0] = load8(cur.Q + (size_t)(wid * QBLK + r32) * QS + d0 * 16 + hi * 8);
    SLOAD_H(cur.K, cur.V, 0); VMW(); SWRITE_HK(0);
    __syncthreads();
}
__device__ __forceinline__ void attn_block(const BlockRef& cur, const BlockRef& nxt, char* lds, Seam& S) {
    int tid_ = threadIdx.x; asm volatile("" : "+v"(tid_));
    const int tid = tid_, wid = __builtin_amdgcn_readfirstlane(tid >> 6), lane = tid & 63, r32 = lane & 31, hi = lane >> 5;
    const int NT = (cur.P0 + QB) / KVBLK;
    char* V_lds = lds; char* K_lds = lds + 2 * SHM_V;
    float* ws = (float*)(lds + 2 * SHM_V + 2 * SHM_K) + wid * 64; float* li_l = ws, * al_l = ws + 32;
    float m_reg = -1e30f, l_reg = 0; f32x16 o[4] = {};
    const int sr = tid >> 4, sc = (tid & 15) * 8, vst0 = v_st(sr, sc), vst1 = v_st(32 + sr, sc), kws = KSWZ(sr, sc * 2);
    const int vb0 = (int)(uintptr_t)V_lds + v_rd_base(lane);
    const bf16_t* Kh = cur.K; const bf16_t* Vh = cur.V;
    const cu64p mrow = cur.M + (size_t)wid * (32 * 32);
#define RESC(a) do { if (__any((a) < 1.f)) { if (hi == 0) al_l[r32] = (a); asm volatile("s_waitcnt lgkmcnt(0)" ::: "memory");              \
                     for (int d_ = 0; d_ < 4; ++d_) for (int r = 0; r < 16; ++r) o[d_][r] *= al_l[crow(r, hi)]; } } while (0)
#define KBASE(t) ((t) * KVBLK)
#define MASKT(P0_, P1_, t) mask_sel(P0_, P1_, mrow + (size_t)(t) * 32)
    constexpr int NQL = 8;
#define SEAM_K0() do { VMWN(NQL); SWRITE_HK(0); SBAR(); } while (0)
    f32x16 pA0, pA1, pB0, pB1; float mnA, mnB, alA, alB; bf16x8 pa0, pa1, pa2, pa3;
    SWRITE_HV(0); SBAR();
    if (NT > 1) { SLOAD_H(Kh, Vh, KBASE(1)); }
    SBAR(); qkt<0>(pA0, pA1, K_lds, r32, hi, S.qr);
    MASKT(pA0, pA1, 0); partialSM(pA0, pA1, m_reg, mnA, alA);
    if (NT > 1) { VMW(); SWRITE_H(1); }
    __syncthreads();
#define HALF_STEP(PX0, PX1, mnX, alX, PY0, PY1, alY, t, KB, VB, SB) do {                                                      \
        SBAR(); qkt<KB>(PX0, PX1, K_lds, r32, hi, S.qr);                                                         \
        finishSM(PY0, PY1, alY, l_reg, pa0, pa1, pa2, pa3); SBAR();                                                           \
        if ((t) + 1 < NT) { SLOAD_H(Kh, Vh, KBASE((t) + 1)); SBAR(); }                                               \
        pv_tile<VB>(o, vb0, pa0, pa1, pa2, pa3); MASKT(PX0, PX1, (t)); partialSM(PX0, PX1, m_reg, mnX, alX);                                        \
        __syncthreads();                                                                                                      \
        if ((t) + 1 < NT) { VMW(); SWRITE_H(SB); }                                                                          \
        RESC(alX); __syncthreads(); } while (0)
    for (int t = 1; t + 1 < NT; t += 2) {
        HALF_STEP(pB0, pB1, mnB, alB, pA0, pA1, alA, t, 1, 0, 0);
        HALF_STEP(pA0, pA1, mnA, alA, pB0, pB1, alB, t + 1, 0, 1, 1);
    }
    SBAR(); qkt<1>(pB0, pB1, K_lds, r32, hi, S.qr); SBAR();
    SLOAD_H(nxt.K, nxt.V, 0); SBAR();
#pragma unroll
    for (int d0 = 0; d0 < 8; ++d0) S.qr[d0] = load8(nxt.Q + (size_t)(wid * QBLK + r32) * QS + d0 * 16 + hi * 8);
    SBAR();
    finishSM(pA0, pA1, alA, l_reg, pa0, pa1, pa2, pa3); SBAR();
    pv_tile<0>(o, vb0, pa0, pa1, pa2, pa3);
    MASKT(pB0, pB1, NT - 1); partialSM(pB0, pB1, m_reg, mnB, alB); __syncthreads(); RESC(alB);
    finishSM(pB0, pB1, alB, l_reg, pa0, pa1, pa2, pa3); SBAR(); pv_tile<1>(o, vb0, pa0, pa1, pa2, pa3);
    SBAR(); SEAM_K0();
    if (hi == 0) li_l[r32] = l_reg; asm volatile("s_waitcnt lgkmcnt(0)" ::: "memory");
    float rli[16];
#pragma unroll
    for (int r = 0; r < 16; ++r) rli[r] = __builtin_amdgcn_rcpf(li_l[crow(r, hi)]);
    bf16_t* Ow = cur.O + (size_t)(wid * QBLK) * OS;
#pragma unroll
    for (int r = 0; r < 16; ++r) { const int orow = crow(r, hi);
#pragma unroll
        for (int d0 = 0; d0 < 4; ++d0) { const float v = o[d0][r] * rli[r];
            const float vn = __shfl_xor(v, 1);
            if ((r32 & 1) == 0) *(unsigned*)(Ow + (size_t)orow * OS + d0 * 32 + r32) = cvtpk(v, vn); } }
    __syncthreads();
#undef RESC
#undef KBASE
#undef MASKT
#undef SEAM_K0
#undef HALF_STEP
}
#undef ROW
#undef VMW
#undef VMWN
#undef SLOAD_H
#undef SWRITE_HK
#undef SWRITE_HV
#undef SWRITE_H
#undef KSWZ
#undef SBAR
}

#define XB_TMO      128
#define XB_XCNT(j)  (256  + 64 * (j))
#define XB_XSUB(j)  (1280 + 64 * (j))
#define XB_XGEN(j)  (2304 + 64 * (j))
#define XB_TOP      3328
#define XB_TOPGEN   3392
#define XCD_BAR_WORDS 3456
#define XB_SPIN_CAP (1u << 18)

__device__ __forceinline__ unsigned xb_ld(unsigned* p)              { return __hip_atomic_load(p, __ATOMIC_RELAXED, __HIP_MEMORY_SCOPE_AGENT); }
__device__ __forceinline__ unsigned xb_add(unsigned* p, unsigned v) { return __hip_atomic_fetch_add(p, v, __ATOMIC_RELAXED, __HIP_MEMORY_SCOPE_AGENT); }
__device__ __forceinline__ unsigned xb_xcc_id() { return (unsigned)__builtin_amdgcn_s_getreg((3 << 11) | 20) & 0xFu; }
#define XB_SPIN(cond, bar) do { unsigned _sp = 0; while (cond) { __builtin_amdgcn_s_sleep(1); \
    if ((++_sp & 255u) == 0u) { if (xb_ld(&(bar)[XB_TMO])) break; if (_sp > XB_SPIN_CAP) { atomicAdd(&(bar)[XB_TMO], 1u); break; } } } } while (0)

struct XcdBarrier {
    unsigned* bar; unsigned x;
    volatile LAS unsigned* st;
};

__device__ __forceinline__ XcdBarrier xcd_barrier_post(unsigned* bar, volatile LAS unsigned* st) {
    XcdBarrier b; b.bar = bar; b.x = xb_xcc_id(); b.st = st;
    if (threadIdx.x == 0) (void)xb_add(&bar[XB_XCNT(b.x)], 1u);
    return b;
}
__device__ __forceinline__ void xcd_barrier_complete(unsigned* bar, unsigned x, unsigned& nloc, unsigned& nx) {
    const unsigned G = gridDim.x * gridDim.y * gridDim.z;
    unsigned sum, cnt, mine, sp = 0u;
    for (;;) {
        sum = 0u; cnt = 0u; mine = 0u;
#pragma unroll
        for (unsigned j = 0; j < 16; ++j) { const unsigned c = xb_ld(&bar[XB_XCNT(j)]); sum += c; cnt += (c > 0u) ? 1u : 0u; mine = (j == x) ? c : mine; }
        if (sum == G) break;
        __builtin_amdgcn_s_sleep(1);
        if ((++sp & 255u) == 0u) { if (xb_ld(&bar[XB_TMO])) break; if (sp > XB_SPIN_CAP) { atomicAdd(&bar[XB_TMO], 1u); break; } }
    }
    nloc = mine > 0u ? mine : 1u; nx = cnt > 0u ? cnt : 1u;
}

__device__ __forceinline__ void xcd_barrier(const XcdBarrier& b) {
    asm volatile("s_waitcnt vmcnt(0)" ::: "memory");
    __syncthreads();
    if (threadIdx.x == 0) {
        unsigned* bar = b.bar;
        __builtin_amdgcn_s_waitcnt(0);
        unsigned nloc = b.st[0], nx = b.st[1];
        if (nloc == 0u) { xcd_barrier_complete(bar, b.x, nloc, nx); b.st[0] = nloc; b.st[1] = nx; }
        const unsigned old = xb_add(&bar[XB_XSUB(b.x)], 1u);
        const unsigned gen = old / nloc;
        if (old + 1u == (gen + 1u) * nloc) {
            __builtin_amdgcn_fence(__ATOMIC_RELEASE, "agent");
            asm volatile("s_waitcnt vmcnt(0)" ::: "memory");
            const unsigned og = xb_add(&bar[XB_TOP], 1u);
            const unsigned tg = og / nx;
            if (og + 1u == (tg + 1u) * nx) xb_add(&bar[XB_TOPGEN], 1u);
            else XB_SPIN(xb_ld(&bar[XB_TOPGEN]) == tg, bar);
            __builtin_amdgcn_fence(__ATOMIC_ACQUIRE, "agent");
            xb_add(&bar[XB_XGEN(b.x)], 1u);
            asm volatile("s_waitcnt vmcnt(0)" ::: "memory");
        } else {
            XB_SPIN(xb_ld(&bar[XB_XGEN(b.x)]) == gen, bar);
            __builtin_amdgcn_fence(__ATOMIC_ACQUIRE, "agent");
            asm volatile("s_waitcnt vmcnt(0)" ::: "memory");
        }
    }
    __syncthreads();
}

struct Args { const void* in[15]; float* out; unsigned char* ws; int ph_lo, ph_hi, li, pad; };
struct Frame {
    LAS unsigned char* lds;
    int tid, lane, wave, G;
    int gw, ngw;
};
__device__ __forceinline__ Frame mkframe(LAS unsigned char* lds) {
    Frame F; int t = threadIdx.x; asm volatile("" : "+v"(t));
    F.lds = lds; F.tid = t; F.lane = t & 63; F.wave = __builtin_amdgcn_readfirstlane(t >> 6);
    F.G = gridDim.x; F.gw = blockIdx.x * 8 + F.wave; F.ngw = F.G * 8; return F;
}
__device__ __forceinline__ const CAS Args* argp() { const CAS Args* p = (const CAS Args*)__builtin_amdgcn_kernarg_segment_ptr(); asm volatile("" : "+s"(p)); return p; }
#define ARG_F(ap, i) ((const float*)(ap)->in[i])
#define WS_AT(ap, T, off) ((T*)((ap)->ws + (off)))
enum { I_X = 0, I_C, I_POS, I_ADAW, I_ADAB, I_NORMG, I_FINALG, I_WGU, I_WD, I_PWIN, I_PWGRP, I_PSCALE, I_PWOUT, I_DWIN, I_DWOUT };

__device__ __forceinline__ void p0_ada_item(const Frame& F, int item) {
    const CAS Args* ap = argp(); const float* c_in = ARG_F(ap, I_C); const float* ada_w = ARG_F(ap, I_ADAW); const float* ada_b = ARG_F(ap, I_ADAB); float* ADA = WS_AT(ap, float, WS_ADA);
    LAS float* sc = (LAS float*)F.lds;
    LAS float* red = sc + 4 * DM;
    for (int i = F.tid; i < 4 * DM; i += 512) { const float v = c_in[i]; sc[i] = v / (1.f + __expf(-v)); }
    __syncthreads();
    const int l = item / 72, chunk = item % 72, e0 = chunk * 256 + 4 * F.lane;
    const float* wp = ada_w + ((size_t)l * DM + (size_t)F.wave * 256) * ADA_E + e0;
    f32x4 a0 = {0.f, 0.f, 0.f, 0.f}, a1 = a0, a2 = a0, a3 = a0;
    const LAS float* s0 = sc + F.wave * 256;
#pragma unroll 8
    for (int d = 0; d < 256; ++d) { const f32x4 xv = *(const f32x4*)(wp + (size_t)d * ADA_E);
        a0 += xv * s0[d]; a1 += xv * s0[DM + d]; a2 += xv * s0[2 * DM + d]; a3 += xv * s0[3 * DM + d]; }
    LAS f32x4* rp = (LAS f32x4*)(red + (F.wave * 4) * 256) + F.lane;
    rp[0] = a0; rp[64] = a1; rp[128] = a2; rp[192] = a3;
    __syncthreads();
#pragma unroll
    for (int i = 0; i < 2; ++i) { const int o = F.tid + 512 * i, b = o >> 8, col = o & 255; float s = 0.f;
#pragma unroll
        for (int w = 0; w < 8; ++w) s += red[(w * 4 + b) * 256 + col];
        const int e = chunk * 256 + col;
        ADA[(size_t)(b * 2 + l) * ADA_E + e] = s + ada_b[l * ADA_E + e]; }
    __syncthreads();
}
__device__ __forceinline__ int cvt_pos(int perm, int n) {
    if (perm == 1) return n < 16 ? 2 * n : (n < 32 ? 2 * (n - 16) + 1 : n);
    if (perm == 2) return n < 8 ? 2 * n : (n < 16 ? 2 * (n - 8) + 1 : n);
    return n;
}
struct CvtJob { const float* W; int Nsrc, c0, nvalid; bf16_t* Bt; int ldb, drow0, perm; const float* rscale; };
__device__ __forceinline__ void cvt_load(const CvtJob& J, int k0, f32x4 (&va)[8], f32x4 (&vb)[8], int lane) {
    const int gq = lane >> 4, q = lane & 15;
    const bool valid = 4 * q < J.nvalid;
#pragma unroll
    for (int i = 0; i < 8; ++i) { const int k = k0 + 8 * i + 2 * gq; const float* p = J.W + (size_t)k * J.Nsrc + J.c0 + 4 * q;
        va[i] = valid ? *(const f32x4*)p : (f32x4){0.f, 0.f, 0.f, 0.f}; vb[i] = valid ? *(const f32x4*)(p + J.Nsrc) : (f32x4){0.f, 0.f, 0.f, 0.f}; }
}
__device__ __forceinline__ void cvt_store(const CvtJob& J, int k0, const f32x4 (&va)[8], const f32x4 (&vb)[8], LAS unsigned* scr, int lane) {
    const int gq = lane >> 4, q = lane & 15;
    int prow[4];
#pragma unroll
    for (int e = 0; e < 4; ++e) prow[e] = cvt_pos(J.perm, 4 * q + e) * 33;
#pragma unroll
    for (int i = 0; i < 8; ++i) { const int k = k0 + 8 * i + 2 * gq; float sa = 1.f, sb = 1.f;
        if (J.rscale) { sa = J.rscale[k]; sb = J.rscale[k + 1]; }
#pragma unroll
        for (int e = 0; e < 4; ++e) scr[prow[e] + 4 * i + gq] = cvt_pk_bf16(va[i][e] * sa, vb[i][e] * sb); }
    LDS_WAIT(); asm volatile("" ::: "memory");
    const int c = lane & 7;
#pragma unroll
    for (int jj = 0; jj < 8; ++jj) { const int n = (lane >> 3) + 8 * jj; const LAS unsigned* s = scr + n * 33 + 4 * c;
        u32x4 o; o.x = s[0]; o.y = s[1]; o.z = s[2]; o.w = s[3];
        *(u32x4*)(J.Bt + (size_t)(J.drow0 + n) * J.ldb + k0 + 8 * c) = o; }
    LDS_WAIT(); asm volatile("" ::: "memory");
}
constexpr int CH_WGU = 4 * 4 * 176, CH_WD = 4 * 11 * 32, CH_PWIN = 4 * 32, CH_PWGRP = 4 * 8, CH_PWOUT = 4 * 32, CH_DWIN = 4 * 66, CH_DWOUT = 4 * 32;
constexpr int CH_TOTAL = CH_WGU + CH_WD + CH_PWIN + CH_PWGRP + CH_PWOUT + CH_DWIN + CH_DWOUT;
__device__ __forceinline__ void p0_cvt_chunk(int ch, LAS unsigned* scr, int lane) {
    const CAS Args* ap = argp(); int r = ch; CvtJob J; int kc;
    J.nvalid = 64; J.perm = 0; J.rscale = nullptr;
    if (r < CH_WGU) { const int mat = r / (4 * 176); r -= mat * (4 * 176); const int nb = r / 4; kc = 8 * (r % 4); const int c0 = 64 * nb;
        const int is_u = c0 >= FF ? 1 : 0, hid = c0 - is_u * FF;
        J.W = ARG_F(ap, I_WGU) + (size_t)mat * DM * 2 * FF; J.Nsrc = 2 * FF; J.c0 = c0; J.Bt = WS_AT(ap, bf16_t, WS_WGU) + (size_t)mat * 2 * FF * DM; J.ldb = DM; J.drow0 = 256 * (hid >> 7) + 128 * is_u + (hid & 127); }
    else if ((r -= CH_WGU) < CH_WD) { const int mat = r / (11 * 32); r -= mat * (11 * 32); const int nb = r / 11; kc = 8 * (r % 11);
        J.W = ARG_F(ap, I_WD) + (size_t)mat * FF * DM; J.Nsrc = DM; J.c0 = 64 * nb; J.Bt = WS_AT(ap, bf16_t, WS_WD) + (size_t)mat * DM * FF; J.ldb = FF; J.drow0 = 64 * nb; }
    else if ((r -= CH_WD) < CH_PWIN) { const int nb = r / 4; kc = 8 * (r % 4); J.W = ARG_F(ap, I_PWIN); J.Nsrc = DM; J.c0 = 64 * nb; J.Bt = WS_AT(ap, bf16_t, WS_PWIN); J.ldb = DM; J.drow0 = 64 * nb; }
    else if ((r -= CH_PWIN) < CH_PWGRP) { const int g = r / 8, nb = r % 8; kc = 0; J.W = ARG_F(ap, I_PWGRP) + (size_t)g * 512 * 512; J.Nsrc = 512; J.c0 = 64 * nb; J.Bt = WS_AT(ap, bf16_t, WS_PWGRP); J.ldb = 512; J.drow0 = g * 512 + 64 * nb; }
    else if ((r -= CH_PWGRP) < CH_PWOUT) { const int nb = r / 4; kc = 8 * (r % 4); J.W = ARG_F(ap, I_PWOUT); J.Nsrc = DM; J.c0 = 64 * nb; J.Bt = WS_AT(ap, bf16_t, WS_PWOUT); J.ldb = DM; J.drow0 = 64 * nb; J.rscale = ARG_F(ap, I_PSCALE); }
    else if ((r -= CH_PWOUT) < CH_DWIN) { const int nb = r / 4; kc = 8 * (r % 4); const int c0 = 64 * nb;
        if (c0 < 2560) J.perm = ((c0 & 127) == 0) ? 1 : 0; else if (c0 < 3072) J.perm = 0; else if (c0 < 4160) J.perm = 2; else { J.perm = 0; J.nvalid = 16; }
        J.W = ARG_F(ap, I_DWIN); J.Nsrc = DSA_IN; J.c0 = c0; J.Bt = WS_AT(ap, bf16_t, WS_DWIN); J.ldb = DM; J.drow0 = c0; }
    else { r -= CH_DWIN; const int nb = r / 4; kc = 8 * (r % 4); J.W = ARG_F(ap, I_DWOUT); J.Nsrc = DM; J.c0 = 64 * nb; J.Bt = WS_AT(ap, bf16_t, WS_DWOUT); J.ldb = DM; J.drow0 = 64 * nb; }
    f32x4 a0[8], b0[8], a1[8], b1[8];
    const int kb = 64 * kc;
    cvt_load(J, kb, a0, b0, lane);
#pragma unroll 1
    for (int j = 0; j < 8; j += 2) {
        cvt_load(J, kb + 64 * (j + 1), a1, b1, lane);
        cvt_store(J, kb + 64 * j, a0, b0, scr, lane);
        if (j + 2 < 8) cvt_load(J, kb + 64 * (j + 2), a0, b0, lane);
        cvt_store(J, kb + 64 * (j + 1), a1, b1, scr, lane);
    }
}
__device__ __forceinline__ void p0_prologue(const Frame& F, int rep) {
    __syncthreads();
    for (int it = blockIdx.x; it < 144; it += F.G) p0_ada_item(F, it);
    { const CAS Args* ap = argp(); const int* pos = (const int*)ap->in[I_POS]; float* cosq = WS_AT(ap, float, WS_COSQ); float* sinq = WS_AT(ap, float, WS_SINQ); float* cosi = WS_AT(ap, float, WS_COSI); float* sini = WS_AT(ap, float, WS_SINI);
    for (int row = F.gw; row < NTOK; row += F.ngw) {
        if (F.lane < 24) { const float p = (float)pos[row]; const bool isq = F.lane < 16; const int i = isq ? F.lane : F.lane - 16;
            float sn, cs; sincos_acc(p * (isq ? INVF_Q[i] : INVF_I[i]), sn, cs);
            if (isq) { cosq[(size_t)row * 16 + i] = cs; sinq[(size_t)row * 16 + i] = sn; } else { cosi[(size_t)row * 8 + i] = cs; sini[(size_t)row * 8 + i] = sn; } }
    } }
    { const size_t n16 = (size_t)(DSA_NPAD - 4224) * DM * 2 / 16; u32x4* zp = (u32x4*)(WS_AT(argp(), bf16_t, WS_DWIN) + (size_t)4224 * DM);
      for (size_t i = (size_t)blockIdx.x * 512 + F.tid; i < n16; i += (size_t)F.G * 512) zp[i] = (u32x4){0u, 0u, 0u, 0u}; }
    __syncthreads();
    LAS unsigned* scr = (LAS unsigned*)(F.lds + F.wave * 8704);
    for (;;) {
        int it = 0; if (F.lane == 0) it = (int)__hip_atomic_fetch_add(WS_AT(argp(), unsigned, WS_CTL) + CW_QUEUE + 64 * rep, 1u, RLX_AGENT);
        it = __builtin_amdgcn_readfirstlane(it);
        if (it >= CH_TOTAL) break;
        p0_cvt_chunk(it, scr, F.lane);
    }
}

__device__ __forceinline__ void norm_phase(const Frame& F, const float* src, float* cpy, const float* g, const float* mod0  , bf16_t* Y) {
    for (int r0 = 4 * F.gw; r0 < NTOK; r0 += 4 * F.ngw) {
        const int b = r0 / SEQ; const float* mod = mod0 + (size_t)b * 2 * ADA_E;
        f32x4 A[8], Bv[8];
#pragma unroll
        for (int j = 0; j < 8; ++j) { const int col = 4 * F.lane + 256 * j; const f32x4 gv = *(const f32x4*)(g + col), sc = *(const f32x4*)(mod + DM + col);
            A[j] = gv * (sc + 1.0f); Bv[j] = *(const f32x4*)(mod + col); }
        for (int rr = 0; rr < 4; ++rr) { const int row = r0 + rr; const f32x4* xr = (const f32x4*)(src + (size_t)row * DM) + F.lane;
            f32x4 v[8]; float s = 0.f;
#pragma unroll
            for (int j = 0; j < 8; ++j) { v[j] = xr[64 * j]; s += (v[j].x * v[j].x + v[j].y * v[j].y) + (v[j].z * v[j].z + v[j].w * v[j].w); }
            const float rstd = 1.0f / sqrtf(wave_sum(s) * (1.0f / DM) + RMS_EPS);
            if (cpy) { f32x4* cr = (f32x4*)(cpy + (size_t)row * DM) + F.lane;
#pragma unroll
                for (int j = 0; j < 8; ++j) cr[64 * j] = v[j]; }
            u32x2* yr = (u32x2*)(Y + (size_t)row * DM) + F.lane;
#pragma unroll
            for (int j = 0; j < 8; ++j) { const f32x4 o = v[j] * rstd * A[j] + Bv[j]; u32x2 w; w.x = cvt_pk_bf16(o.x, o.y); w.y = cvt_pk_bf16(o.z, o.w); yr[64 * j] = w; } }
    }
}
__device__ __forceinline__ void final_norm_phase(const Frame& F, float* H, const float* g) {
    for (int row = F.gw; row < NTOK; row += F.ngw) { f32x4* xr = (f32x4*)(H + (size_t)row * DM) + F.lane;
        f32x4 v[8]; float s = 0.f;
#pragma unroll
        for (int j = 0; j < 8; ++j) { v[j] = xr[64 * j]; s += (v[j].x * v[j].x + v[j].y * v[j].y) + (v[j].z * v[j].z + v[j].w * v[j].w); }
        const float rstd = 1.0f / sqrtf(wave_sum(s) * (1.0f / DM) + RMS_EPS);
#pragma unroll
        for (int j = 0; j < 8; ++j) xr[64 * j] = v[j] * rstd * *(const f32x4*)(g + 4 * F.lane + 256 * j); }
}
__device__ __forceinline__ void pool_phase(const Frame& F, const bf16_t* U, bf16_t* Pp) {
    for (int task = F.gw; task < NB * 4 * (SEQ / 16); task += F.ngw) {
        const int run = task % (SEQ / 16), g = (task / (SEQ / 16)) & 3, b = task / (4 * (SEQ / 16));
        const int w = 2 << g, t0 = run * 16;
        const bf16_t* ub = U + (size_t)b * SEQ * DM + 512 * g + 8 * F.lane; bf16_t* pb = Pp + (size_t)b * SEQ * DM + 512 * g + 8 * F.lane;
        float s[8];
#pragma unroll
        for (int e = 0; e < 8; ++e) s[e] = 0.f;
        for (int j = (t0 - w + 1 > 0 ? t0 - w + 1 : 0); j < t0; ++j) { const u32x4 x = *(const u32x4*)(ub + (size_t)j * DM);
            s[0] += bf_lo(x.x); s[1] += bf_hi(x.x); s[2] += bf_lo(x.y); s[3] += bf_hi(x.y); s[4] += bf_lo(x.z); s[5] += bf_hi(x.z); s[6] += bf_lo(x.w); s[7] += bf_hi(x.w); }
#pragma unroll 4
        for (int t = t0; t < t0 + 16; ++t) { const u32x4 x = *(const u32x4*)(ub + (size_t)t * DM);
            float u[8] = {bf_lo(x.x), bf_hi(x.x), bf_lo(x.y), bf_hi(x.y), bf_lo(x.z), bf_hi(x.z), bf_lo(x.w), bf_hi(x.w)};
            if (t > t0 && t - w >= 0) { const u32x4 y = *(const u32x4*)(ub + (size_t)(t - w) * DM);
                s[0] -= bf_lo(y.x); s[1] -= bf_hi(y.x); s[2] -= bf_lo(y.y); s[3] -= bf_hi(y.y); s[4] -= bf_lo(y.z); s[5] -= bf_hi(y.z); s[6] -= bf_lo(y.w); s[7] -= bf_hi(y.w); }
            const float inv = 1.0f / (float)((t + 1) < w ? (t + 1) : w);
            float o[8];
#pragma unroll
            for (int e = 0; e < 8; ++e) { s[e] += u[e]; o[e] = s[e] * inv - u[e]; }
            u32x4 wv; wv.x = cvt_pk_bf16(o[0], o[1]); wv.y = cvt_pk_bf16(o[2], o[3]); wv.z = cvt_pk_bf16(o[4], o[5]); wv.w = cvt_pk_bf16(o[6], o[7]);
            *(u32x4*)(pb + (size_t)t * DM) = wv; }
    }
}
__device__ __forceinline__ void dk_phase(const Frame& F) {
    const CAS Args* ap = argp(); const float* KWP = WS_AT(ap, float, WS_BIG + BIG_KWP); const float* cosi = WS_AT(ap, float, WS_COSI); const float* sini = WS_AT(ap, float, WS_SINI);
    bf16_t* KI = WS_AT(ap, bf16_t, WS_KI); float* WI = WS_AT(ap, float, WS_WI);
    const int nthr = F.G * 512;
    for (int i = blockIdx.x * 512 + F.tid; i < NTOK * 20; i += nthr) { const int row = i / 20, q = i % 20;
        f32x4 s = {0.f, 0.f, 0.f, 0.f};
#pragma unroll
        for (int k = 0; k < 8; ++k) s += *(const f32x4*)(KWP + ((size_t)k * NTOK + row) * 128 + 4 * q);
        if (q < 16) {
            if (q < 4) { const float c0 = cosi[(size_t)row * 8 + 2 * q], s0 = sini[(size_t)row * 8 + 2 * q], c1 = cosi[(size_t)row * 8 + 2 * q + 1], s1 = sini[(size_t)row * 8 + 2 * q + 1];
                const f32x4 a = s; s.x = a.x * c0 - a.y * s0; s.y = a.y * c0 + a.x * s0; s.z = a.z * c1 - a.w * s1; s.w = a.w * c1 + a.z * s1; }
            u32x2 w; w.x = cvt_pk_bf16(s.x, s.y); w.y = cvt_pk_bf16(s.z, s.w); *(u32x2*)(KI + (size_t)row * 64 + 4 * q) = w;
        } else *(f32x4*)(WI + (size_t)row * 16 + 4 * (q - 16)) = s;
    }
}

constexpr int MN_PITCH = 65;
constexpr int MN_OFF = RING_BYTES + 1024;
static_assert(MN_OFF + 32 * MN_PITCH * 4 <= LDS_BYTES, "LDS map: select phase");
__device__ __forceinline__ void select_unit(const Frame& F, int b, int grp) {
    const CAS Args* ap = argp(); const bf16_t* QI = WS_AT(ap, bf16_t, WS_BIG + BIG_QI); const bf16_t* KI = WS_AT(ap, bf16_t, WS_KI); const float* WI = WS_AT(ap, float, WS_WI);
    LAS unsigned* MN = (LAS unsigned*)(F.lds + MN_OFF);
    const int lane = F.lane, half = lane >> 5, l31 = lane & 31;
    LAS float* SC = (LAS float*)F.lds + (F.wave * 2 + half) * SEQ + l31;
#pragma unroll 1
    for (int round = 0; round < 2; ++round) {
        const int tok0 = 32 * grp + 16 * round + 2 * F.wave, myt = tok0 + half;
        const int ntile = ((tok0 + 1) >> 5) + 1;
        {
            const int at = (l31 >> 2) & 1, ah = (l31 & 3) + 4 * (l31 >> 3);
            const bf16_t* qp = QI + (size_t)(b * SEQ + tok0 + at) * 1024 + ah * 64 + 8 * half;
            bf16x8 af[4];
#pragma unroll
            for (int s = 0; s < 4; ++s) af[s] = *(const bf16x8*)(qp + 16 * s);
            float wv[16];
            { const f32x4* wp = (const f32x4*)(WI + (size_t)(b * SEQ + myt) * 16);
#pragma unroll
              for (int i = 0; i < 4; ++i) { const f32x4 x = wp[i]; wv[4 * i] = x.x; wv[4 * i + 1] = x.y; wv[4 * i + 2] = x.z; wv[4 * i + 3] = x.w; } }
            const bf16_t* kp = KI + (size_t)(b * SEQ + l31) * 64 + 8 * half;
            const int ngrp = (ntile + 3) >> 2;
            bf16x8 fa[16], fb[16];
#define SEL_LOAD(dst, g) do { _Pragma("unroll") for (int tt = 0; tt < 4; ++tt) _Pragma("unroll") for (int s = 0; s < 4; ++s) dst[4 * tt + s] = *(const bf16x8*)(kp + (size_t)(4 * (g) + tt) * 32 * 64 + 16 * s); } while (0)
#define SEL_SCORE(src, g) do { _Pragma("unroll") for (int tt = 0; tt < 4; ++tt) { f32x16 acc = {}; \
                _Pragma("unroll") for (int s = 0; s < 4; ++s) acc = __builtin_amdgcn_mfma_f32_32x32x16_bf16(af[s], src[4 * tt + s], acc, 0, 0, 0); \
                float t = 0.f; _Pragma("unroll") for (int i = 0; i < 16; ++i) t += wv[i] * fmaxf(acc[i], 0.f); \
                const int tile = 4 * (g) + tt; SC[32 * tile] = (32 * tile + l31 <= myt) ? t : -__builtin_inff(); } } while (0)
            SEL_LOAD(fa, 0);
#pragma unroll 1
            for (int g = 0; g < ngrp; g += 2) {
                if (g + 1 < ngrp) SEL_LOAD(fb, g + 1);
                SEL_SCORE(fa, g);
                if (g + 2 < ngrp) SEL_LOAD(fa, g + 2);
                if (g + 1 < ngrp) SEL_SCORE(fb, g + 1);
            }
#undef SEL_LOAD
#undef SEL_SCORE
        }
        LDS_WAIT(); asm volatile("" ::: "memory");
        float v[64];
#pragma unroll
        for (int i = 0; i < 64; ++i) { const float x = SC[32 * i]; v[i] = (i < ntile) ? x : -__builtin_inff(); }
        float thr = -3.0e38f;
        {
            float mn = 3.0e38f, mx = -3.0e38f;
#pragma unroll
            for (int i = 0; i < 64; ++i) { mx = fmaxf(mx, v[i]); mn = fminf(mn, v[i] == -__builtin_inff() ? 3.0e38f : v[i]); }
#pragma unroll
            for (int o = 1; o < 32; o <<= 1) { mx = fmaxf(mx, __shfl_xor(mx, o)); mn = fminf(mn, __shfl_xor(mn, o)); }
            float lo = mn, hi = mx + fabsf(mx) * 1e-6f + 1e-30f;
            bool done = (myt + 1 <= TOPK);
#pragma unroll 1
            for (int it = 0; it < 64; ++it) {
                if (__all(done)) break;
                const float mid = 0.5f * (lo + hi);
                int c = 0;
#pragma unroll
                for (int i = 0; i < 64; ++i) c += (v[i] >= mid) ? 1 : 0;
#pragma unroll
                for (int o = 1; o < 32; o <<= 1) c += __shfl_xor(c, o);
                if (!done) {
                    if (!(mid > lo && mid < hi)) done = true;
                    else if (c >= TOPK) { lo = mid; if (c == TOPK) done = true; }
                    else hi = mid;
                }
            }
            if (myt + 1 > TOPK) thr = lo;
        }
        unsigned m0 = 0u, m1 = 0u;
#pragma unroll
        for (int i = 0; i < 64; ++i) { const unsigned long long bal = __ballot(v[i] >= thr);
            if (lane == i) { m0 = (unsigned)bal; m1 = (unsigned)(bal >> 32); }
            if ((i & 3) == 3) __builtin_amdgcn_sched_barrier(0); }
        const int trow = 16 * round + 2 * F.wave;
        MN[trow * MN_PITCH + lane] = m0; MN[(trow + 1) * MN_PITCH + lane] = m1;
    }
    __syncthreads();
    unsigned long long* mout = WS_AT(ap, unsigned long long, WS_MASK) + (size_t)((b * 64 + grp) * 32) * 32;
#pragma unroll 1
    for (int j = F.wave; j < 32; j += 8) {
        const unsigned d0 = MN[l31 * MN_PITCH + 2 * j], d1 = MN[l31 * MN_PITCH + 2 * j + 1];
        unsigned wlo = 0u, whi = 0u;
#pragma unroll
        for (int r = 0; r < 16; ++r) { const int cc = (r & 3) + 8 * (r >> 2);
            const unsigned long long b0 = __ballot(((d0 >> (cc + 4 * half)) & 1u) != 0u), b1 = __ballot(((d1 >> (cc + 4 * half)) & 1u) != 0u);
            if (lane == r) { wlo = (unsigned)b0; whi = (unsigned)(b0 >> 32); }
            if (lane == 16 + r) { wlo = (unsigned)b1; whi = (unsigned)(b1 >> 32); }
            if ((r & 1) == 1) __builtin_amdgcn_sched_barrier(0); }
        if (lane < 32) mout[(size_t)j * 32 + lane] = ((unsigned long long)whi << 32) | wlo;
    }
    __syncthreads();
}

constexpr int N_PHASES = 25;
#ifndef MK_KINDS
#define MK_KINDS 0xffff
#endif
#define HAVE(k) (((MK_KINDS) >> (k)) & 1)
#ifndef MK_REP_KIND
#define MK_REP_KIND -1
#endif
#ifndef MK_REP_N
#define MK_REP_N 2
#endif
#define REPS(k) ((k) == (MK_REP_KIND) ? (MK_REP_N) : 1)
#define REPEAT(k) _Pragma("unroll 1") for (int rep_ = 0; rep_ < REPS(k); ++rep_)

__global__ void __launch_bounds__(NWAVES * 64, 2) mk_fwd(Args args) {
    extern __shared__ __attribute__((aligned(16))) unsigned char lds[];
    LAS unsigned char* const ldsp = (LAS unsigned char*)lds;
    for (int u = threadIdx.x; u < (LDS_BYTES - LDSCTL_OFF) / 4; u += NWAVES * 64) ((LAS unsigned*)(ldsp + LDSCTL_OFF))[u] = 0u;
    __syncthreads();
    XcdBarrier bar = xcd_barrier_post((unsigned*)(args.ws + WS_CTL) + CW_BAR + args.li * XCD_BAR_WORDS, (volatile LAS unsigned*)(ldsp + MISC_OFF) + 8);
    const int NG = gridDim.x;

    const int lo = args.ph_lo, hi = args.ph_hi;
    int ph = 0;
#define IN_PH() (lo <= ph && ph < hi)
#define SEAM() do { if (lo <= ph && ph + 1 < hi) xcd_barrier(bar); ++ph; } while (0)
    const int bx = (int)blockIdx.x;
    constexpr long TILE_A = 256L * DM * 2;
#define ADA_AT(ap, l, sub, k) (WS_AT(ap, float, WS_ADA) + (size_t)(l) * ADA_E + ((sub) * 3 + (k)) * DM)

    if (HAVE(0) && IN_PH()) REPEAT(0) { const Frame F = mkframe(ldsp); p0_prologue(F, rep_); }
    SEAM();
#pragma unroll 1
    for (int l = 0; l < 2; ++l) {
#pragma unroll 1
        for (int f = 0; f < 2; ++f) {
            if (f == 1) {
                if (HAVE(1) && IN_PH()) REPEAT(1) { const CAS Args* ap = argp();
                    const Frame F = mkframe(ldsp); norm_phase(F, ap->out, nullptr, ARG_F(ap, I_NORMG) + (size_t)(l * 3 + 1) * DM, ADA_AT(ap, l, 1, 0), WS_AT(ap, bf16_t, WS_Y)); }
                SEAM();
                if (l == 0) {
                    if (HAVE(4) && IN_PH()) REPEAT(4) { const CAS Args* ap = argp(); pg8::Gemm g{WS_AT(ap, bf16_t, WS_Y), WS_AT(ap, bf16_t, WS_PWIN), DM, DM, DM}; pg8::StaticOrder S; S.init(32, 8, NG, bx, TILE_A, 0, 0, TILE_A);
                        pg8::EpiBf16 E{WS_AT(ap, bf16_t, WS_BIG + BIG_U), DM}; pg8::gemm_phase<pg8::EpiBf16, pg8::StaticOrder, true, true>(ldsp, g, S, E); }
                    SEAM();
                    if (HAVE(5) && IN_PH()) REPEAT(5) { const CAS Args* ap = argp(); const Frame F = mkframe(ldsp); pool_phase(F, WS_AT(ap, bf16_t, WS_BIG + BIG_U), WS_AT(ap, bf16_t, WS_BIG + BIG_P)); }
                    SEAM();
                    if (HAVE(6) && IN_PH()) REPEAT(6) { const CAS Args* ap = argp(); pg8::Gemm g{WS_AT(ap, bf16_t, WS_BIG + BIG_P), WS_AT(ap, bf16_t, WS_PWGRP), DM, 512, 512}; pg8::StaticOrder S; S.init(32, 8, NG, bx, TILE_A, 1, 512 * 2, 256L * 512 * 2);
                        pg8::EpiBf16 E{WS_AT(ap, bf16_t, WS_BIG + BIG_V), DM}; pg8::gemm_phase<pg8::EpiBf16, pg8::StaticOrder, true, true>(ldsp, g, S, E); }
                    SEAM();
                    if (HAVE(7) && IN_PH()) REPEAT(7) { const CAS Args* ap = argp(); pg8::Gemm g{WS_AT(ap, bf16_t, WS_BIG + BIG_V), WS_AT(ap, bf16_t, WS_PWOUT), DM, DM, DM}; pg8::StaticOrder S; S.init(32, 8, NG, bx, TILE_A, 0, 0, TILE_A);
                        pg8::EpiResid E{ap->out, ADA_AT(ap, l, 1, 2), rep_ ? 0.0f : 1.0f}; pg8::gemm_phase<pg8::EpiResid, pg8::StaticOrder, true, true>(ldsp, g, S, E); }
                    SEAM();
                } else {
                    if (HAVE(8) && IN_PH()) REPEAT(8) {
                        { const CAS Args* ap = argp(); pg8::Gemm g{WS_AT(ap, bf16_t, WS_Y), WS_AT(ap, bf16_t, WS_DWIN), DM, DM, DM}; pg8::StaticOrder S; S.init(32, 16, NG, bx, TILE_A, 0, 0, TILE_A);
                          pg8::EpiDsaIn E{WS_AT(ap, bf16_t, WS_BIG + BIG_Q), WS_AT(ap, bf16_t, WS_BIG + BIG_K), WS_AT(ap, bf16_t, WS_BIG + BIG_VV), WS_AT(ap, bf16_t, WS_BIG + BIG_QI),
                                              WS_AT(ap, float, WS_COSQ), WS_AT(ap, float, WS_SINQ), WS_AT(ap, float, WS_COSI), WS_AT(ap, float, WS_SINI)};
                          pg8::gemm_phase<pg8::EpiDsaIn, pg8::StaticOrder, true, true>(ldsp, g, S, E); }
                        __syncthreads();
                        { const CAS Args* ap = argp(); pg8::Gemm g{WS_AT(ap, bf16_t, WS_Y), WS_AT(ap, bf16_t, WS_DWIN) + (size_t)4096 * DM, DM, DM, 256}; pg8::StaticOrder S; S.init(32, 8, NG, bx, TILE_A, 0, 256 * 2, 256 * 2);
                          pg8::EpiKW E{WS_AT(ap, float, WS_BIG + BIG_KWP)}; pg8::gemm_phase<pg8::EpiKW, pg8::StaticOrder, true, true>(ldsp, g, S, E); }
                    }
                    SEAM();
                    if (HAVE(9) && IN_PH()) REPEAT(9) { const Frame F = mkframe(ldsp); dk_phase(F); }
                    SEAM();
                    if (HAVE(10) && IN_PH()) REPEAT(10) { for (int u = bx; u < NB * 64; u += NG) { const Frame F = mkframe(ldsp); select_unit(F, u >> 6, u & 63); } }
                    SEAM();
                    if (HAVE(11) && IN_PH()) REPEAT(11) {
                        for (int L = bx; L < 256; L += NG) {
                            const CAS Args* ap = argp();
                            const bf16_t* Qp = WS_AT(ap, bf16_t, WS_BIG + BIG_Q); const bf16_t* Kp = WS_AT(ap, bf16_t, WS_BIG + BIG_K); const bf16_t* Vp = WS_AT(ap, bf16_t, WS_BIG + BIG_VV);
                            bf16_t* Op = WS_AT(ap, bf16_t, WS_O); const unsigned long long* Mp = WS_AT(ap, unsigned long long, WS_MASK);
                            const int xcd = L & 7, k = L >> 3, kvg = 2 * xcd + (k >> 4), r = k & 15, b = kvg >> 2, gk = kvg & 3, h = 4 * gk + (r >> 2), pr = r & 3;
                            attn::BlockRef cur, nxt;
                            { const int qb = pr; const size_t row0 = (size_t)b * SEQ + (size_t)qb * 256;
                              cur.Q = Qp + row0 * DM + h * 128; cur.O = Op + row0 * DM + h * 128; cur.K = Kp + (size_t)b * SEQ * 512 + gk * 128; cur.V = Vp + (size_t)b * SEQ * 512 + gk * 128;
                              cur.M = (attn::cu64p)(Mp + (size_t)((b * 64 + qb * 8) * 32) * 32); cur.P0 = qb * 256; }
                            { const int qb = 7 - pr; const size_t row0 = (size_t)b * SEQ + (size_t)qb * 256;
                              nxt.Q = Qp + row0 * DM + h * 128; nxt.O = Op + row0 * DM + h * 128; nxt.K = cur.K; nxt.V = cur.V;
                              nxt.M = (attn::cu64p)(Mp + (size_t)((b * 64 + qb * 8) * 32) * 32); nxt.P0 = qb * 256; }
                            attn::Seam S;
                            attn::attn_prime(cur, (char*)lds, S);
#pragma unroll 1
                            for (int i = 0; i < 2; ++i) { attn::attn_block(cur, nxt, (char*)lds, S); cur = nxt; }
                        }
                    }
                    SEAM();
                    if (HAVE(12) && IN_PH()) REPEAT(12) { const CAS Args* ap = argp(); pg8::Gemm g{WS_AT(ap, bf16_t, WS_O), WS_AT(ap, bf16_t, WS_DWOUT), DM, DM, DM}; pg8::StaticOrder S; S.init(32, 8, NG, bx, TILE_A, 0, 0, TILE_A);
                        pg8::EpiResid E{ap->out, ADA_AT(ap, l, 1, 2), rep_ ? 0.0f : 1.0f}; pg8::gemm_phase<pg8::EpiResid, pg8::StaticOrder, true, true>(ldsp, g, S, E); }
                    SEAM();
                }
            }
            const int sub = f == 0 ? 0 : 2;
            if (HAVE(1) && IN_PH()) REPEAT(1) { const CAS Args* ap = argp(); const bool first = (l == 0 && f == 0); const Frame F = mkframe(ldsp);
                norm_phase(F, first ? ARG_F(ap, I_X) : (const float*)ap->out, first ? ap->out : nullptr, ARG_F(ap, I_NORMG) + (size_t)(l * 3 + sub) * DM, ADA_AT(ap, l, sub, 0), WS_AT(ap, bf16_t, WS_Y)); }
            SEAM();
            if (HAVE(2) && IN_PH()) REPEAT(2) { const CAS Args* ap = argp(); pg8::Gemm g{WS_AT(ap, bf16_t, WS_Y), WS_AT(ap, bf16_t, WS_WGU) + (size_t)(l * 2 + f) * 2 * FF * DM, DM, DM, DM}; pg8::StaticOrder S; S.init(32, 44, NG, bx, TILE_A, 0, 0, TILE_A);
                pg8::EpiSwiglu E{WS_AT(ap, bf16_t, WS_BIG), FF}; pg8::gemm_phase<pg8::EpiSwiglu, pg8::StaticOrder, true, true>(ldsp, g, S, E); }
            SEAM();
            if (HAVE(3) && IN_PH()) REPEAT(3) { const CAS Args* ap = argp(); pg8::Gemm g{WS_AT(ap, bf16_t, WS_BIG), WS_AT(ap, bf16_t, WS_WD) + (size_t)(l * 2 + f) * DM * FF, FF, FF, FF}; pg8::StaticOrder S; S.init(32, 8, NG, bx, 256L * FF * 2, 0, 0, 256L * FF * 2);
                pg8::EpiResid E{ap->out, ADA_AT(ap, l, sub, 2), rep_ ? 0.0f : 0.5f}; pg8::gemm_phase<pg8::EpiResid, pg8::StaticOrder, true, true>(ldsp, g, S, E); }
            SEAM();
        }
    }
    if (HAVE(13) && IN_PH()) REPEAT(13) { const CAS Args* ap = argp(); const Frame F = mkframe(ldsp); final_norm_phase(F, ap->out, ARG_F(ap, I_FINALG)); }
#undef IN_PH
#undef SEAM
}

extern "C" void kernel_launch(void* const* d_in, const int* in_sizes, int n_in, void* d_out, int out_size, void* d_ws, size_t ws_size, hipStream_t stream) {
    static int grid = 0;
    if (grid == 0) {
        if (n_in != 15 || out_size != NTOK * DM || ws_size < WS_END) { fprintf(stderr, "kernel_launch: unexpected shapes (n_in %d, out %d, ws %zu)\n", n_in, out_size, ws_size); grid = -1; return; }
        int dev = 0, cus = 0, per_cu = 0;
        if (hipGetDevice(&dev) != hipSuccess || hipDeviceGetAttribute(&cus, hipDeviceAttributeMultiprocessorCount, dev) != hipSuccess) { grid = -1; return; }
        if (hipFuncSetAttribute((const void*)mk_fwd, hipFuncAttributeMaxDynamicSharedMemorySize, LDS_BYTES) != hipSuccess) { fprintf(stderr, "kernel_launch: hipFuncSetAttribute failed\n"); grid = -1; return; }
        if (hipOccupancyMaxActiveBlocksPerMultiprocessor(&per_cu, (const void*)mk_fwd, NWAVES * 64, LDS_BYTES) != hipSuccess || per_cu < 1) { fprintf(stderr, "kernel_launch: occupancy query says %d\n", per_cu); }
        (void)hipGetLastError();
        grid = cus;
    }
    if (grid < 0) return;
    (void)in_sizes;
    if (hipMemsetAsync((char*)d_ws + WS_CTL, 0, CTL_ZERO_BYTES, stream) != hipSuccess) return;
    Args a{};
    for (int i = 0; i < 15; ++i) a.in[i] = d_in[i];
    a.out = (float*)d_out; a.ws = (unsigned char*)d_ws;
#if MK_N_LAUNCHES == 1
    a.ph_lo = 0; a.ph_hi = N_PHASES; a.li = 0; a.pad = 0;
    hipLaunchKernelGGL(mk_fwd, dim3(grid), dim3(NWAVES * 64), LDS_BYTES, stream, a);
#else
    for (int p = 0; p < N_PHASES; ++p) { a.ph_lo = p; a.ph_hi = p + 1; a.li = 0; a.pad = 0;
        hipLaunchKernelGGL(mk_fwd, dim3(grid), dim3(NWAVES * 64), LDS_BYTES, stream, a); }
#endif
}
```
